# Optimizing an MI355X kernel written in HIP

```python
import math
import jax, jax.numpy as jnp
from jax import lax
import numpy as np

D_MODEL = 1024
BATCH = 8
SEQ = 2048
DEPTH = 1

CHUNK = 64
Q_BLOCK = 128
D_RNN = D_MODEL
RNN_BLOCKS = 16
RNN_BW = D_RNN // RNN_BLOCKS
CONV_W = 4
LRU_C = 8.0
N_DIFF_HEADS = 8
DIFF_DH = D_MODEL // (2 * N_DIFF_HEADS)
D_QK = N_DIFF_HEADS * 2 * DIFF_DH
D_ATTN = N_DIFF_HEADS * 2 * DIFF_DH
X_OFF = 0
Y_OFF = X_OFF + D_RNN
Q_OFF = Y_OFF + D_RNN
K_OFF = Q_OFF + D_QK
V_OFF = K_OFF + D_QK
G_OFF = V_OFF + D_ATTN
D_IN = G_OFF + 2 * D_MODEL
N_EXPERTS = 64
TOP_K = 8
N_GROUPS = 8
TOPK_GROUPS = 4
D_EXPERT = 256
D_SHARED = 256
ROUTED_SCALE = 2.5
TOK_BLOCK = 128
ALPHA = (2.0 * DEPTH) ** 0.25
BETA = (8.0 * DEPTH) ** -0.25
LN_EPS = 1e-5
RMS_EPS = 1e-5

kernel_name = 'hybrid_rglru_diffattn_moe_block'


def _ln0(x):
    xf = x.astype(jnp.float32)
    mu = jnp.mean(xf, axis=-1, keepdims=True)
    xc = xf - mu
    var = jnp.mean(jnp.square(xc), axis=-1, keepdims=True)
    return xc * lax.rsqrt(var + LN_EPS)


def _layer_norm(x, g, b):
    return _ln0(x) * g.astype(jnp.float32) + b.astype(jnp.float32)


def _modulate(x, shift, scale):
    return (_ln0(x) * (1.0 + scale[:, None, :]) + shift[:, None, :]).astype(x.dtype)


def _causal_depthwise_conv(x, w, b):
    y = lax.conv_general_dilated(
        x, w[:, None, :].astype(x.dtype), window_strides=(1,), padding=[(CONV_W - 1, 0)],
        dimension_numbers=('NWC', 'WIO', 'NWC'), feature_group_count=x.shape[-1])
    return y + b.astype(x.dtype)


def _rg_lru(x, w_a, b_a, w_i, b_i, lru_lambda):
    B, S, _ = x.shape
    xf = x.astype(jnp.float32)
    xb = xf.reshape(B, S, RNN_BLOCKS, RNN_BW)
    r = jax.nn.sigmoid(jnp.einsum('bsnd,nde->bsne', xb, w_a.astype(jnp.float32)).reshape(B, S, D_RNN) + b_a.astype(jnp.float32))
    i = jax.nn.sigmoid(jnp.einsum('bsnd,nde->bsne', xb, w_i.astype(jnp.float32)).reshape(B, S, D_RNN) + b_i.astype(jnp.float32))
    log_a = -LRU_C * r * jax.nn.softplus(-lru_lambda.astype(jnp.float32))
    a = jnp.exp(log_a)
    mult = jnp.sqrt(jnp.maximum(-jnp.expm1(2.0 * log_a), 0.0))
    u = xf * i * mult

    def combine(left, right):
        a_l, b_l = left
        a_r, b_r = right
        return a_l * a_r, a_r * b_l + b_r

    _, h = lax.associative_scan(combine, (a, u), axis=1)
    return h


def _diff_attention(q, k, v, lam, subln_g, lam_init):
    B, S = q.shape[0], q.shape[1]
    nb = S // Q_BLOCK
    scale = DIFF_DH ** -0.5
    qb = q.reshape(B, nb, Q_BLOCK, N_DIFF_HEADS, 2, DIFF_DH).transpose(1, 0, 3, 4, 2, 5)
    kt = k.transpose(0, 2, 3, 1, 4).astype(jnp.float32)
    vt = v.transpose(0, 2, 1, 3).astype(jnp.float32)
    key_chunk = jnp.arange(S) // CHUNK

    def block(args):
        q_blk, blk = args
        scores = jnp.einsum('bhcqd,bhckd->bhcqk', q_blk.astype(jnp.float32), kt) * scale
        q_chunk = (blk * Q_BLOCK + jnp.arange(Q_BLOCK)) // CHUNK
        mask = key_chunk[None, :] <= q_chunk[:, None]
        scores = jnp.where(mask, scores, -jnp.inf)
        p = jax.nn.softmax(scores, axis=-1)
        attn = p[:, :, 0] - lam * p[:, :, 1]
        return jnp.einsum('bhqk,bhkv->bhqv', attn, vt)

    o = lax.map(block, (qb, jnp.arange(nb)))
    o = o.transpose(1, 0, 3, 2, 4).reshape(B, S, N_DIFF_HEADS, 2 * DIFF_DH)
    o = o * lax.rsqrt(jnp.mean(jnp.square(o), axis=-1, keepdims=True) + RMS_EPS) * subln_g.astype(jnp.float32)
    o = o * (1.0 - lam_init)
    return o.reshape(B, S, D_ATTN)


def _token_mixer(h, w_in, conv_w, conv_b, lru_w_a, lru_b_a, lru_w_i, lru_b_i, lru_lambda,
                 lam_q1, lam_k1, lam_q2, lam_k2, subln_g, p_rnn, p_attn, w_out, lam_init):
    B, S, _ = h.shape
    proj = h @ w_in
    xr = proj[..., X_OFF:Y_OFF]
    yr = proj[..., Y_OFF:Q_OFF]
    q = proj[..., Q_OFF:K_OFF].reshape(B, S, N_DIFF_HEADS, 2, DIFF_DH)
    k = proj[..., K_OFF:V_OFF].reshape(B, S, N_DIFF_HEADS, 2, DIFF_DH)
    v = proj[..., V_OFF:G_OFF].reshape(B, S, N_DIFF_HEADS, 2 * DIFF_DH)
    gates = jax.nn.sigmoid(proj[..., G_OFF:D_IN].astype(jnp.float32))
    g_rnn, g_attn = gates[..., :D_MODEL], gates[..., D_MODEL:]
    xr = _causal_depthwise_conv(xr, conv_w, conv_b)
    hr = _rg_lru(xr, lru_w_a, lru_b_a, lru_w_i, lru_b_i, lru_lambda)
    ya = (hr * jax.nn.gelu(yr.astype(jnp.float32))).astype(h.dtype)
    branch_a = (ya @ p_rnn).astype(jnp.float32)
    lam = (jnp.exp(jnp.sum(lam_q1.astype(jnp.float32) * lam_k1.astype(jnp.float32)))
           - jnp.exp(jnp.sum(lam_q2.astype(jnp.float32) * lam_k2.astype(jnp.float32))) + lam_init)
    yb = _diff_attention(q, k, v, lam, subln_g, lam_init).astype(h.dtype)
    branch_b = (yb @ p_attn).astype(jnp.float32)
    merged = (g_rnn * branch_a + g_attn * branch_b).astype(h.dtype)
    return (merged @ w_out).astype(jnp.float32)


def _moe(u, w_router, router_bias, we_gate, we_up, we_down, ws_gate, ws_up, ws_down):
    B, S, D = u.shape
    n = B * S
    t = u.reshape(n, D)
    s = jax.nn.sigmoid((t @ w_router).astype(jnp.float32))
    sel = s + router_bias.astype(jnp.float32)
    grp = sel.reshape(n, N_GROUPS, N_EXPERTS // N_GROUPS)
    grp_score = jnp.sum(lax.top_k(grp, 2)[0], axis=-1)
    _, gidx = lax.top_k(grp_score, TOPK_GROUPS)
    gmask = jnp.sum(jax.nn.one_hot(gidx, N_GROUPS, dtype=jnp.float32), axis=1) > 0
    emask = jnp.repeat(gmask, N_EXPERTS // N_GROUPS, axis=1)
    sel = jnp.where(emask, sel, -jnp.inf)
    _, eidx = lax.top_k(sel, TOP_K)
    w = jnp.take_along_axis(s, eidx, axis=-1)
    w = w / jnp.sum(w, axis=-1, keepdims=True) * ROUTED_SCALE
    gate = jnp.sum(jax.nn.one_hot(eidx, N_EXPERTS, dtype=jnp.float32) * w[..., None], axis=1)
    tb = t.reshape(n // TOK_BLOCK, TOK_BLOCK, D)
    gb = gate.reshape(n // TOK_BLOCK, TOK_BLOCK, N_EXPERTS)

    def expert_block(args):
        tk, gk = args
        hg = jnp.einsum('nd,edf->nef', tk, we_gate).astype(jnp.float32)
        hu = jnp.einsum('nd,edf->nef', tk, we_up).astype(jnp.float32)
        act = (jax.nn.silu(hg) * hu * gk[..., None]).astype(tk.dtype)
        return jnp.einsum('nef,efd->nd', act, we_down).astype(jnp.float32)

    routed = lax.map(expert_block, (tb, gb)).reshape(n, D)
    shared = ((jax.nn.silu((t @ ws_gate).astype(jnp.float32)) * (t @ ws_up).astype(jnp.float32)).astype(t.dtype) @ ws_down).astype(jnp.float32)
    return (routed + shared).reshape(B, S, D)


def setup_inputs(seed: int = 0) -> dict:
    key = jax.random.key(seed)
    ks = jax.random.split(key, 32)

    def nrm(k, shape, scale):
        return jax.random.normal(k, shape, jnp.float32) * scale

    L = DEPTH
    x = nrm(ks[0], (BATCH, SEQ, D_MODEL), 1.0)
    c = nrm(ks[1], (BATCH, D_MODEL), 1.0)
    w_ada = nrm(ks[2], (L, D_MODEL, 6 * D_MODEL), D_MODEL ** -0.5)
    b_ada = nrm(ks[3], (L, 6 * D_MODEL), 0.02)
    w_in = nrm(ks[4], (L, D_MODEL, D_IN), D_MODEL ** -0.5)
    w_in = w_in.at[:, :, V_OFF:G_OFF].multiply(BETA)
    conv_w = nrm(ks[5], (L, CONV_W, D_RNN), CONV_W ** -0.5)
    conv_b = nrm(ks[6], (L, D_RNN), 0.02)
    lru_w_a = nrm(ks[7], (L, RNN_BLOCKS, RNN_BW, RNN_BW), RNN_BW ** -0.5)
    lru_b_a = nrm(ks[8], (L, D_RNN), 0.02)
    lru_w_i = nrm(ks[9], (L, RNN_BLOCKS, RNN_BW, RNN_BW), RNN_BW ** -0.5)
    lru_b_i = nrm(ks[10], (L, D_RNN), 0.02)
    a8 = jax.random.uniform(ks[11], (L, D_RNN), jnp.float32, 0.9, 0.999)
    a0 = a8 ** (1.0 / LRU_C)
    lru_lambda = jnp.log(a0) - jnp.log1p(-a0)
    lam_q1 = nrm(ks[12], (L, DIFF_DH), 0.1)
    lam_k1 = nrm(ks[13], (L, DIFF_DH), 0.1)
    lam_q2 = nrm(ks[14], (L, DIFF_DH), 0.1)
    lam_k2 = nrm(ks[15], (L, DIFF_DH), 0.1)
    subln_g = 1.0 + nrm(ks[16], (L, 2 * DIFF_DH), 0.02)
    p_rnn = nrm(ks[17], (L, D_RNN, D_MODEL), D_RNN ** -0.5)
    p_attn = nrm(ks[18], (L, D_ATTN, D_MODEL), D_ATTN ** -0.5)
    w_out = nrm(ks[19], (L, D_MODEL, D_MODEL), D_MODEL ** -0.5 * BETA)
    ln1_g = 1.0 + nrm(ks[20], (L, D_MODEL), 0.02)
    ln1_b = nrm(ks[21], (L, D_MODEL), 0.02)
    w_router = nrm(ks[22], (L, D_MODEL, N_EXPERTS), D_MODEL ** -0.5)
    router_bias = nrm(ks[23], (L, N_EXPERTS), 0.01)
    we_gate = nrm(ks[24], (L, N_EXPERTS, D_MODEL, D_EXPERT), D_MODEL ** -0.5)
    we_up = nrm(ks[25], (L, N_EXPERTS, D_MODEL, D_EXPERT), D_MODEL ** -0.5)
    we_down = nrm(ks[26], (L, N_EXPERTS, D_EXPERT, D_MODEL), D_EXPERT ** -0.5 * BETA)
    ws_gate = nrm(ks[27], (L, D_MODEL, D_SHARED), D_MODEL ** -0.5)
    ws_up = nrm(ks[28], (L, D_MODEL, D_SHARED), D_MODEL ** -0.5)
    ws_down = nrm(ks[29], (L, D_SHARED, D_MODEL), D_SHARED ** -0.5 * BETA)
    ln2_g = 1.0 + nrm(ks[30], (L, D_MODEL), 0.02)
    ln2_b = nrm(ks[31], (L, D_MODEL), 0.02)
    return {'x': x, 'c': c, 'w_ada': w_ada, 'b_ada': b_ada, 'w_in': w_in, 'conv_w': conv_w, 'conv_b': conv_b,
            'lru_w_a': lru_w_a, 'lru_b_a': lru_b_a, 'lru_w_i': lru_w_i, 'lru_b_i': lru_b_i, 'lru_lambda': lru_lambda,
            'lam_q1': lam_q1, 'lam_k1': lam_k1, 'lam_q2': lam_q2, 'lam_k2': lam_k2, 'subln_g': subln_g,
            'p_rnn': p_rnn, 'p_attn': p_attn, 'w_out': w_out, 'ln1_g': ln1_g, 'ln1_b': ln1_b,
            'w_router': w_router, 'router_bias': router_bias, 'we_gate': we_gate, 'we_up': we_up, 'we_down': we_down,
            'ws_gate': ws_gate, 'ws_up': ws_up, 'ws_down': ws_down, 'ln2_g': ln2_g, 'ln2_b': ln2_b}


def reference(x, c, w_ada, b_ada, w_in, conv_w, conv_b, lru_w_a, lru_b_a, lru_w_i, lru_b_i, lru_lambda,
              lam_q1, lam_k1, lam_q2, lam_k2, subln_g, p_rnn, p_attn, w_out, ln1_g, ln1_b,
              w_router, router_bias, we_gate, we_up, we_down, ws_gate, ws_up, ws_down, ln2_g, ln2_b):
    dtype = x.dtype
    cond = jax.nn.silu(c.astype(jnp.float32))
    for l in range(DEPTH):
        lam_init = 0.8 - 0.6 * math.exp(-0.3 * l)
        ada = cond @ w_ada[l].astype(jnp.float32) + b_ada[l].astype(jnp.float32)
        sh1, sc1, g1, sh2, sc2, g2 = jnp.split(ada, 6, axis=-1)
        h = _modulate(x, sh1, sc1)
        mix = _token_mixer(h, w_in[l], conv_w[l], conv_b[l], lru_w_a[l], lru_b_a[l], lru_w_i[l], lru_b_i[l],
                           lru_lambda[l], lam_q1[l], lam_k1[l], lam_q2[l], lam_k2[l], subln_g[l],
                           p_rnn[l], p_attn[l], w_out[l], lam_init)
        x = _layer_norm(ALPHA * x.astype(jnp.float32) + g1[:, None, :] * mix, ln1_g[l], ln1_b[l]).astype(dtype)
        u = _modulate(x, sh2, sc2)
        ffn = _moe(u, w_router[l], router_bias[l], we_gate[l], we_up[l], we_down[l], ws_gate[l], ws_up[l], ws_down[l])
        x = _layer_norm(ALPHA * x.astype(jnp.float32) + g2[:, None, :] * ffn, ln2_g[l], ln2_b[l]).astype(dtype)
    return x
```

```cpp
#define MK_N_LAUNCHES 14
#include <hip/hip_runtime.h>
#include <cstdio>
#include <cstdint>

#define LAS __attribute__((address_space(3)))
#define GAS __attribute__((address_space(1)))
typedef unsigned short bf16_t;
typedef short bf16x8 __attribute__((ext_vector_type(8)));
typedef short s16x4 __attribute__((ext_vector_type(4)));
typedef float f32x4 __attribute__((ext_vector_type(4)));
typedef float f32x2 __attribute__((ext_vector_type(2)));
typedef float f32x16 __attribute__((ext_vector_type(16)));
typedef unsigned u32x4 __attribute__((ext_vector_type(4)));
typedef unsigned u32x2 __attribute__((ext_vector_type(2)));

constexpr int BATCH = 8, SEQ = 2048, DM = 1024, M = BATCH * SEQ, DIN = 7168;
constexpr int NEXP = 64, NEXP1 = 65  , TOPK = 8, DEXP = 256, NSLOTK = 9  ;
constexpr float ALPHA_DN = 1.189207115002721f;
constexpr float LN_EPS = 1e-5f, RMS_EPS = 1e-5f;
constexpr float LOG2E = 1.4426950408889634f;
constexpr float QSCALE = 0.125f * LOG2E;
constexpr float LAM_INIT = 0.2f;

__device__ __forceinline__ unsigned f2bf(float f) { unsigned u = __builtin_bit_cast(unsigned, f); return (u + 0x7fffu + ((u >> 16) & 1u)) >> 16; }
__device__ __forceinline__ unsigned pk2(float lo, float hi) { return f2bf(lo) | (f2bf(hi) << 16); }
__device__ __forceinline__ float bf_lo(unsigned w) { return __builtin_bit_cast(float, w << 16); }
__device__ __forceinline__ float bf_hi(unsigned w) { return __builtin_bit_cast(float, w & 0xffff0000u); }
__device__ __forceinline__ float fast_sigmoid(float x) { return __builtin_amdgcn_rcpf(1.0f + __builtin_amdgcn_exp2f(-x * LOG2E)); }
__device__ __forceinline__ float gelu_tanh(float x) { const float z = 1.5957691216057308f * (x + 0.044715f * x * x * x); return x * __builtin_amdgcn_rcpf(1.0f + __builtin_amdgcn_exp2f(-z * LOG2E)); }

namespace pg8 {
constexpr int BM = 256, BK = 64, HALF = 128, HTB = HALF * BK * 2  , STAGE_BYTES = 8 * HTB, NXCD = 8, WGM = 8;

__host__ __device__ __forceinline__ int lds_byte(int r, int c) { const int st = (r >> 4) * 2 + (c >> 5), rr = r & 15, cc = c & 31, ob = rr * 64 + cc * 2; return st * 1024 + (ob ^ (((ob >> 9) & 1) << 5)); }
__host__ __device__ __forceinline__ void stage_rc(int b, int& R, int& C) { const int st = b / 1024, sb = b % 1024, swz = sb ^ (((sb >> 9) & 1) << 5); R = (st >> 1) * 16 + swz / 64; C = (st & 1) * 32 + (swz % 64) / 2; }
__host__ __device__ __forceinline__ int perm32(int rho) { const int n = rho >> 4, i = rho & 15; return 8 * (i >> 2) + 4 * n + (i & 3); }

struct Unit { int pm, pn, e, nrows; };
struct Gemm { const bf16_t* A; const bf16_t* Bt; int K; int ksplit; long a2delta; };

template <class Epi, class Sched, bool ALIGN_EPI>
__device__ __forceinline__ void gemm_phase(LAS unsigned char* lds, const Gemm g, const Sched& S, const Epi& E) {
    const int tid = threadIdx.x, wid = __builtin_amdgcn_readfirstlane(tid >> 6), lane = tid & 63, wr = wid >> 2, wc = wid & 3, fr = lane & 15, fq = lane >> 4;
    const int K = g.K, nt = K / BK;
    int RA[2]; unsigned CA[2], voffB[2];
#pragma unroll
    for (int i = 0; i < 2; ++i) { int R, C; stage_rc(tid * 16 + i * 8192, R, C); const int Rb = (R & ~31) + perm32(R & 31);
        RA[i] = R; CA[i] = (unsigned)C * 2u; voffB[i] = (unsigned)(Rb * K + C) * 2u; }
    const size_t kstep = (size_t)(BK * 2);
    const size_t hstepB = (size_t)HALF * K * 2;
    const unsigned ldsw = (unsigned)wid * 1024u;
    const int aoff = lds_byte(wr * 64 + fr, fq * 8), boff = lds_byte(wc * 32 + fr, fq * 8);
#define PG8_SA(b, h) (((b) * 2 + (h)) * HTB)
#define PG8_SB(b, h) ((4 + (b) * 2 + (h)) * HTB)
#define PG8_STAGE_B(bufoff, gbase) do { _Pragma("unroll") for (int _i = 0; _i < 2; ++_i) \
        __builtin_amdgcn_global_load_lds((const unsigned*)((const char*)(gbase) + voffB[_i]), (LAS unsigned*)(lds + (bufoff) + ldsw + _i * 8192), 16, 0, 0); } while (0)
#define PG8_STAGE_A(bufoff, gbase, offs) do { _Pragma("unroll") for (int _i = 0; _i < 2; ++_i) \
        __builtin_amdgcn_global_load_lds((const unsigned*)((const char*)(gbase) + (offs)[_i]), (LAS unsigned*)(lds + (bufoff) + ldsw + _i * 8192), 16, 0, 0); } while (0)
#define PG8_LDA(dst, b, h) do { _Pragma("unroll") for (int m = 0; m < 4; ++m) _Pragma("unroll") for (int k = 0; k < 2; ++k) dst[m][k] = *(const LAS bf16x8*)(lds + PG8_SA(b, h) + aoff + m * 2048 + k * 1024); } while (0)
#define PG8_LDB(dst, b, h) do { _Pragma("unroll") for (int n = 0; n < 2; ++n) _Pragma("unroll") for (int k = 0; k < 2; ++k) dst[n][k] = *(const LAS bf16x8*)(lds + PG8_SB(b, h) + boff + n * 2048 + k * 1024); } while (0)
#define PG8_MMA(ai, bj, At, Bt) do { __builtin_amdgcn_s_setprio(1); _Pragma("unroll") for (int m = 0; m < 4; ++m) _Pragma("unroll") for (int n = 0; n < 2; ++n) _Pragma("unroll") for (int k = 0; k < 2; ++k) \
        acc[ai][bj][m][n] = __builtin_amdgcn_mfma_f32_16x16x32_bf16(Bt[n][k], At[m][k], acc[ai][bj][m][n], 0, 0, 0); __builtin_amdgcn_s_setprio(0); } while (0)
#define PG8_WAIT_V(n) asm volatile("s_waitcnt vmcnt(" #n ")" ::: "memory")
#define PG8_WAIT_L(n) asm volatile("s_waitcnt lgkmcnt(" #n ")" ::: "memory")
#define PG8_BAR __builtin_amdgcn_s_barrier()
#define PG8_SCHED __builtin_amdgcn_sched_barrier(0)
    Unit cur, nxt; int ui = 0;
    if (!S.next(0, cur)) return;
    unsigned so0[2], so1[2], no0[2], no1[2];
#pragma unroll
    for (int i = 0; i < 2; ++i) { so0[i] = S.a_off(cur, RA[i]) + CA[i]; so1[i] = S.a_off(cur, HALF + RA[i]) + CA[i]; }
    f32x4 acc[2][2][4][2];
#pragma unroll
    for (int a = 0; a < 2; ++a)
#pragma unroll
        for (int b = 0; b < 2; ++b)
#pragma unroll
            for (int m = 0; m < 4; ++m)
#pragma unroll
                for (int n = 0; n < 2; ++n) acc[a][b][m][n] = (f32x4){0.f, 0.f, 0.f, 0.f};
    bf16x8 At[4][2], B0[2][2], B1[2][2];
    const char* Ab = (const char*)g.A;
    const int ksplit = g.ksplit; const long a2d = g.a2delta;
#define PG8_KA(tt) (Ab + (size_t)(tt) * kstep + ((tt) >= ksplit ? a2d : 0l))
    const char* cB = (const char*)g.Bt + S.b_off(cur);
    { const char* a0 = PG8_KA(0); const char* a1 = PG8_KA(1);
      PG8_STAGE_B(PG8_SB(0, 0), cB); PG8_STAGE_B(PG8_SB(0, 1), cB + hstepB); PG8_STAGE_A(PG8_SA(0, 0), a0, so0); PG8_STAGE_A(PG8_SA(0, 1), a0, so1);
      if (wr == 1) PG8_BAR;
      PG8_WAIT_V(2); PG8_BAR;
      PG8_STAGE_B(PG8_SB(1, 0), cB + kstep); PG8_STAGE_A(PG8_SA(1, 0), a1, so0); PG8_STAGE_B(PG8_SB(1, 1), cB + hstepB + kstep);
      PG8_WAIT_V(6); PG8_BAR; }
    for (;;) {
        const bool has_next = S.next(ui + 1, nxt);
        if (has_next) {
#pragma unroll
            for (int i = 0; i < 2; ++i) { no0[i] = S.a_off(nxt, RA[i]) + CA[i]; no1[i] = S.a_off(nxt, HALF + RA[i]) + CA[i]; }
        } else {
#pragma unroll
            for (int i = 0; i < 2; ++i) { no0[i] = so0[i]; no1[i] = so1[i]; }
        }
        const char* nB = has_next ? (const char*)g.Bt + S.b_off(nxt) : cB;
        for (int t = 0; t < nt; t += 2) {
            const bool last = (t == nt - 2);
            if constexpr (Epi::HAS_MID) { if (t == (nt >> 1)) E.mid(acc, cur, wr, wc, fr, fq); }
            const char* a1 = PG8_KA(t + 1);
            const int t2 = last ? 0 : t + 2;
            const char* a2 = PG8_KA(t2); const char* a3 = PG8_KA(t2 + 1);
            const char* b2 = last ? nB : cB + (size_t)(t + 2) * kstep; const char* b3 = b2 + kstep;
            PG8_LDB(B0, 0, 0); PG8_LDB(B1, 0, 1); PG8_SCHED; PG8_LDA(At, 0, 0); PG8_STAGE_A(PG8_SA(1, 1), a1, so1);
            if (last) {
#pragma unroll
                for (int i = 0; i < 2; ++i) { so0[i] = no0[i]; so1[i] = no1[i]; }
            }
            PG8_WAIT_V(8); PG8_WAIT_L(0); PG8_BAR; PG8_MMA(0, 0, At, B0); PG8_MMA(0, 1, At, B1); PG8_BAR; PG8_SCHED;
            PG8_LDA(At, 0, 1); PG8_STAGE_B(PG8_SB(0, 0), b2); PG8_STAGE_B(PG8_SB(0, 1), b2 + hstepB); PG8_STAGE_A(PG8_SA(0, 0), a2, so0);
            PG8_WAIT_V(8); PG8_WAIT_L(0); PG8_BAR; PG8_MMA(1, 0, At, B0); PG8_MMA(1, 1, At, B1); PG8_BAR; PG8_SCHED;
            PG8_LDB(B0, 1, 0); PG8_LDB(B1, 1, 1); PG8_SCHED; PG8_LDA(At, 1, 0); PG8_STAGE_A(PG8_SA(0, 1), a2, so1);
            PG8_WAIT_V(8); PG8_WAIT_L(0); PG8_BAR; PG8_MMA(0, 0, At, B0); PG8_MMA(0, 1, At, B1); PG8_BAR; PG8_SCHED;
            PG8_LDA(At, 1, 1); PG8_STAGE_B(PG8_SB(1, 0), b3); PG8_STAGE_B(PG8_SB(1, 1), b3 + hstepB); PG8_STAGE_A(PG8_SA(1, 0), a3, so0);
            PG8_WAIT_V(8); PG8_WAIT_L(0); PG8_BAR; PG8_MMA(1, 0, At, B0); PG8_MMA(1, 1, At, B1); PG8_BAR; PG8_SCHED;
        }
        if constexpr (ALIGN_EPI) { if (wr == 0) PG8_BAR; }
        E(acc, cur, wr, wc, fr, fq);
        if (!has_next) break;
#pragma unroll
        for (int a = 0; a < 2; ++a)
#pragma unroll
            for (int b = 0; b < 2; ++b)
#pragma unroll
                for (int m = 0; m < 4; ++m)
#pragma unroll
                    for (int n = 0; n < 2; ++n) acc[a][b][m][n] = (f32x4){0.f, 0.f, 0.f, 0.f};
        cur = nxt; cB = nB; ++ui;
        if constexpr (ALIGN_EPI) { if (wr == 1) PG8_BAR; }
    }
    PG8_WAIT_V(0);
    if constexpr (!ALIGN_EPI) { if (wr == 0) PG8_BAR; }
    PG8_BAR;
#undef PG8_SA
#undef PG8_SB
#undef PG8_STAGE_A
#undef PG8_STAGE_B
#undef PG8_LDA
#undef PG8_LDB
#undef PG8_MMA
#undef PG8_WAIT_V
#undef PG8_WAIT_L
#undef PG8_BAR
#undef PG8_SCHED
#undef PG8_KA
}

struct DenseSched {
    int nM, nN, nwg, G, c; unsigned lda_bytes; int Kb;
    __device__ void init(int M_, int N_, int K_, int G_, int c_, unsigned lda_bytes_) { nM = M_ / BM; nN = N_ / BM; nwg = nM * nN; G = G_; c = c_; lda_bytes = lda_bytes_; Kb = K_ * 2; }
    __device__ __forceinline__ bool next(int i, Unit& u) const {
        const long L = (long)i * G + c; if (L >= nwg) return false;
        int wgid = (int)L; { const int q = nwg / NXCD, r = nwg % NXCD, xcd = wgid % NXCD, off = wgid / NXCD; wgid = (xcd < r ? xcd * (q + 1) : r * (q + 1) + (xcd - r) * q) + off; }
        const int nig = WGM * nN, gid = wgid / nig, fm = gid * WGM, gsz = (nM - fm) < WGM ? (nM - fm) : WGM;
        u.pm = fm + ((wgid % nig) % gsz); u.pn = (wgid % nig) / gsz; u.e = 0; u.nrows = BM; return true;
    }
    __device__ __forceinline__ unsigned a_off(const Unit& u, int r) const { return (unsigned)(u.pm * BM + r) * lda_bytes; }
    __device__ __forceinline__ size_t b_off(const Unit& u) const { return (size_t)u.pn * BM * (size_t)Kb; }
};
}

constexpr size_t MiB = 1u << 20;
constexpr size_t WS_CTL = 0, CTL_ZERO_BYTES = 1 * MiB;
constexpr size_t WS_ADA = 1 * MiB;
constexpr size_t WS_WIN = 2 * MiB;
constexpr size_t WS_WBR = 16 * MiB;
constexpr size_t WS_WOUT = 20 * MiB;
constexpr size_t WS_WRTR = 22 * MiB;
constexpr size_t WS_W2 = 23 * MiB;
constexpr size_t WS_HB = 56 * MiB;
constexpr size_t WS_XR = 88 * MiB;
constexpr size_t WS_YG = 120 * MiB;
constexpr size_t WS_Q = 152 * MiB;
constexpr size_t WS_K = 184 * MiB;
constexpr size_t WS_V = 216 * MiB;
constexpr size_t WS_G = 248 * MiB;
constexpr size_t WS_LOG = 56 * MiB;
constexpr size_t WS_LIST = 60 * MiB;
constexpr size_t WS_TOKW = 64 * MiB;
constexpr size_t WS_H = 68 * MiB;
constexpr size_t WS_Y = 149 * MiB;
constexpr size_t WS_U = 149 * MiB;
constexpr size_t WS_W1 = 181 * MiB;
constexpr size_t WS_END = 312 * MiB;
constexpr size_t W1_STRIDE = 512 * 1024 * 2, W2_STRIDE = 1024 * 256 * 2;
constexpr int CW_TMO = 0, CW_CODE = 1, CW_BAR = 4096, CW_CNT = 16384  ;

namespace pg8 {

struct EpiInProj {
    static constexpr bool HAS_MID = false;
    bf16_t *XR, *YG, *Q, *Kb, *V, *G;
    __device__ __forceinline__ void mid(f32x4 (&)[2][2][4][2], const Unit&, int, int, int, int) const {}
    __device__ __forceinline__ void operator()(const f32x4 (&acc)[2][2][4][2], const Unit& u, int wr, int wc, int fr, int fq) const {
        const int sec = u.pn >> 2;
        bf16_t* base; int ldc = 1024, colt = (u.pn & 3) * 256, act = 0;
        if (sec == 0) base = XR; else if (sec == 1) { base = YG; act = 1; } else if (sec == 2) { base = Q; act = 2; } else if (sec == 3) base = Kb; else if (sec == 4) base = V;
        else { base = G; ldc = 2048; colt = (u.pn - 20) * 256; act = 3; }
        const int row0 = u.pm * BM + wr * 64 + fr, col0 = colt + wc * 32 + 8 * fq;
#pragma unroll
        for (int ai = 0; ai < 2; ++ai)
#pragma unroll
            for (int m = 0; m < 4; ++m) { bf16_t* rowp = base + (size_t)(row0 + ai * HALF + m * 16) * ldc + col0;
#pragma unroll
                for (int bj = 0; bj < 2; ++bj) { f32x4 v0 = acc[ai][bj][m][0], v1 = acc[ai][bj][m][1];
                    if (act == 1) {
#pragma unroll
                        for (int j = 0; j < 4; ++j) { v0[j] = gelu_tanh(v0[j]); v1[j] = gelu_tanh(v1[j]); }
                    } else if (act == 2) { v0 = v0 * QSCALE; v1 = v1 * QSCALE; }
                    else if (act == 3) {
#pragma unroll
                        for (int j = 0; j < 4; ++j) { v0[j] = fast_sigmoid(v0[j]); v1[j] = fast_sigmoid(v1[j]); }
                    }
                    u32x4 w; w.x = pk2(v0[0], v0[1]); w.y = pk2(v0[2], v0[3]); w.z = pk2(v1[0], v1[1]); w.w = pk2(v1[2], v1[3]);
                    *(u32x4*)(rowp + bj * HALF) = w; } }
    }
};

struct EpiBranch {
    static constexpr bool HAS_MID = true;
    const bf16_t* G; bf16_t* O;
    __device__ __forceinline__ void mid(f32x4 (&acc)[2][2][4][2], const Unit& u, int wr, int wc, int fr, int fq) const {
        int row0 = u.pm * BM + wr * 64 + fr; const int col0 = u.pn * BM + wc * 32 + 8 * fq;
        asm volatile("" : "+v"(row0));
#pragma unroll
        for (int ai = 0; ai < 2; ++ai)
#pragma unroll
            for (int m = 0; m < 4; ++m) { const bf16_t* gp = G + (size_t)(row0 + ai * HALF + m * 16) * 2048 + col0;
#pragma unroll
                for (int bj = 0; bj < 2; ++bj) { const u32x4 gr = *(const u32x4*)(gp + bj * HALF), ga = *(const u32x4*)(gp + 1024 + bj * HALF);
#pragma unroll
                    for (int q = 0; q < 4; ++q) { const float r0 = bf_lo(gr[q]) * __builtin_amdgcn_rcpf(fmaxf(bf_lo(ga[q]), 1e-20f)), r1 = bf_hi(gr[q]) * __builtin_amdgcn_rcpf(fmaxf(bf_hi(ga[q]), 1e-20f));
                        acc[ai][bj][m][q >> 1][(q & 1) * 2] *= r0; acc[ai][bj][m][q >> 1][(q & 1) * 2 + 1] *= r1; } } }
    }
    __device__ __forceinline__ void operator()(const f32x4 (&acc)[2][2][4][2], const Unit& u, int wr, int wc, int fr, int fq) const {
        const int row0 = u.pm * BM + wr * 64 + fr, col0 = u.pn * BM + wc * 32 + 8 * fq;
#pragma unroll
        for (int ai = 0; ai < 2; ++ai)
#pragma unroll
            for (int m = 0; m < 4; ++m) { const size_t row = (size_t)(row0 + ai * HALF + m * 16);
#pragma unroll
                for (int bj = 0; bj < 2; ++bj) { const u32x4 ga = *(const u32x4*)(G + row * 2048 + 1024 + col0 + bj * HALF); float o[8];
#pragma unroll
                    for (int q = 0; q < 4; ++q) { o[2 * q] = acc[ai][bj][m][q >> 1][(q & 1) * 2] * fmaxf(bf_lo(ga[q]), 1e-20f); o[2 * q + 1] = acc[ai][bj][m][q >> 1][(q & 1) * 2 + 1] * fmaxf(bf_hi(ga[q]), 1e-20f); }
                    u32x4 w; w.x = pk2(o[0], o[1]); w.y = pk2(o[2], o[3]); w.z = pk2(o[4], o[5]); w.w = pk2(o[6], o[7]);
                    *(u32x4*)(O + row * 1024 + col0 + bj * HALF) = w; } }
    }
};

struct EpiOutProj {
    static constexpr bool HAS_MID = false;
    const float* x; const float* ada; float* out;
    __device__ __forceinline__ void mid(f32x4 (&)[2][2][4][2], const Unit&, int, int, int, int) const {}
    __device__ __forceinline__ void operator()(const f32x4 (&acc)[2][2][4][2], const Unit& u, int wr, int wc, int fr, int fq) const {
        const int row0 = u.pm * BM + wr * 64 + fr, col0 = u.pn * BM + wc * 32 + 8 * fq;
        const float* g1 = ada + (size_t)((u.pm * BM) / SEQ) * 6144 + 2048;
#pragma unroll
        for (int bj = 0; bj < 2; ++bj) { const f32x4 ga = *(const f32x4*)(g1 + col0 + bj * HALF), gb = *(const f32x4*)(g1 + col0 + bj * HALF + 4);
#pragma unroll
            for (int ai = 0; ai < 2; ++ai)
#pragma unroll
                for (int m = 0; m < 4; ++m) { const size_t off = (size_t)(row0 + ai * HALF + m * 16) * 1024 + col0 + bj * HALF;
                    const f32x4 xa = *(const f32x4*)(x + off), xb = *(const f32x4*)(x + off + 4);
                    *(f32x4*)(out + off) = xa * ALPHA_DN + ga * acc[ai][bj][m][0]; *(f32x4*)(out + off + 4) = xb * ALPHA_DN + gb * acc[ai][bj][m][1]; } }
    }
};

struct EpiRouter {
    static constexpr bool HAS_MID = false;
    float* logits;
    __device__ __forceinline__ void mid(f32x4 (&)[2][2][4][2], const Unit&, int, int, int, int) const {}
    __device__ __forceinline__ void operator()(const f32x4 (&acc)[2][2][4][2], const Unit& u, int wr, int wc, int fr, int fq) const {
        if (wc >= 2) return;
        const int row0 = u.pm * BM + wr * 64 + fr, col0 = wc * 32 + 8 * fq;
#pragma unroll
        for (int ai = 0; ai < 2; ++ai)
#pragma unroll
            for (int m = 0; m < 4; ++m) { float* p = logits + (size_t)(row0 + ai * HALF + m * 16) * 64 + col0; *(f32x4*)p = acc[ai][0][m][0]; *(f32x4*)(p + 4) = acc[ai][0][m][1]; }
    }
};

struct ExpertTables { const LAS int* tp; const LAS int* cnt; const LAS unsigned char* rt2e; int RT; };
struct ExpertSched {
    ExpertTables T; int nN, G, c; const unsigned* list; int mode;
    size_t bstride, bsub;
    int pn0;
    __device__ __forceinline__ bool next(int i, Unit& u) const {
        const long L = (long)i * G + c; if (L >= (long)T.RT * nN) return false;
        const int rt = (int)(L / nN); u.pn = (int)(L % nN); const int e = T.rt2e[rt]; u.e = e; u.pm = rt - T.tp[e];
        const int left = T.cnt[e] - u.pm * BM; u.nrows = left < BM ? left : BM; return true;
    }
    __device__ __forceinline__ unsigned a_off(const Unit& u, int r) const {
        if (mode == 1) return (unsigned)((T.tp[u.e] + u.pm) * BM + r) * 512u;
        const int rr = r < u.nrows ? r : u.nrows - 1; const int slot = u.pm * BM + rr;
        const unsigned tok = (u.e == NEXP) ? (unsigned)slot : (list[(size_t)u.e * M + slot] >> 4);
        return tok * 2048u;
    }
    __device__ __forceinline__ size_t b_off(const Unit& u) const { return (size_t)u.e * bstride + (size_t)(pn0 + u.pn) * bsub; }
};

struct EpiGemm1 {
    static constexpr bool HAS_MID = false;
    ExpertTables T; const unsigned* list; const float* tokw; bf16_t* H;
    __device__ __forceinline__ void mid(f32x4 (&)[2][2][4][2], const Unit&, int, int, int, int) const {}
    __device__ __forceinline__ void operator()(const f32x4 (&acc)[2][2][4][2], const Unit& u, int wr, int wc, int fr, int fq) const {
        const int hrow0 = (T.tp[u.e] + u.pm) * BM, col0 = u.pn * HALF + wc * 32 + 8 * fq;
#pragma unroll
        for (int ai = 0; ai < 2; ++ai)
#pragma unroll
            for (int m = 0; m < 4; ++m) { const int r = ai * HALF + wr * 64 + m * 16 + fr;
                if (r < u.nrows) { float w = 1.f;
                    if (u.e != NEXP) { const unsigned ent = list[(size_t)u.e * M + u.pm * BM + r]; w = tokw[(size_t)(ent >> 4) * 8 + (ent & 15u)]; }
                    float o[8];
#pragma unroll
                    for (int n = 0; n < 2; ++n)
#pragma unroll
                        for (int j = 0; j < 4; ++j) { const float gt = acc[ai][0][m][n][j], up = acc[ai][1][m][n][j]; o[4 * n + j] = gt * fast_sigmoid(gt) * up * w; }
                    u32x4 pw; pw.x = pk2(o[0], o[1]); pw.y = pk2(o[2], o[3]); pw.z = pk2(o[4], o[5]); pw.w = pk2(o[6], o[7]);
                    *(u32x4*)(H + (size_t)(hrow0 + r) * 256 + col0) = pw; } }
    }
};

struct EpiGemm2 {
    static constexpr bool HAS_MID = false;
    const unsigned* list; bf16_t* Y;
    __device__ __forceinline__ void mid(f32x4 (&)[2][2][4][2], const Unit&, int, int, int, int) const {}
    __device__ __forceinline__ void operator()(const f32x4 (&acc)[2][2][4][2], const Unit& u, int wr, int wc, int fr, int fq) const {
        const int col0 = u.pn * BM + wc * 32 + 8 * fq;
#pragma unroll
        for (int ai = 0; ai < 2; ++ai)
#pragma unroll
            for (int m = 0; m < 4; ++m) { const int r = ai * HALF + wr * 64 + m * 16 + fr;
                if (r < u.nrows) { unsigned dst;
                    if (u.e != NEXP) { const unsigned ent = list[(size_t)u.e * M + u.pm * BM + r]; dst = (ent >> 4) * NSLOTK + (ent & 15u); } else dst = (unsigned)(u.pm * BM + r) * NSLOTK + 8u;
                    bf16_t* yp = Y + (size_t)dst * 512 + col0;
#pragma unroll
                    for (int bj = 0; bj < 2; ++bj) { const f32x4 v0 = acc[ai][bj][m][0], v1 = acc[ai][bj][m][1];
                        u32x4 w; w.x = pk2(v0[0], v0[1]); w.y = pk2(v0[2], v0[3]); w.z = pk2(v1[0], v1[1]); w.w = pk2(v1[2], v1[3]);
                        *(u32x4*)(yp + bj * HALF) = w; } } }
    }
};
}

namespace att {
constexpr int SLOT = 32768, KOFF = 0, VOFF = 16384, WSF_OFF = 3 * SLOT  , STG_ROW = 132  , STG_BYTES = 32 * STG_ROW * 4;
__device__ __forceinline__ int crow(int r, int hi) { return (r & 3) + 8 * (r >> 2) + 4 * hi; }
__device__ __forceinline__ s16x4 vtr(const LAS unsigned char* p) { typedef short v4i16_t __attribute__((ext_vector_type(4))); return __builtin_bit_cast(s16x4, __builtin_amdgcn_ds_read_tr16_b64_v4i16((LAS v4i16_t*)p)); }

__device__ __forceinline__ void attn_unit(int b, int h, int qb, const bf16_t* Qg, const bf16_t* Kg, const bf16_t* Vg, bf16_t* Og, LAS unsigned char* lds, float lam, const float* subln_g) {
    const int tid = threadIdx.x, lane = tid & 63, r32 = lane & 31, hi = lane >> 5; const int wid = __builtin_amdgcn_readfirstlane(tid >> 6);
    const int c = wid >> 2, wq = wid & 3;
    const size_t rowbase = (size_t)b * SEQ; const int q0 = qb * 128;
    const int NT = 2 * qb + 2, ntw = 2 * qb + 1 + (wq >> 1);
    const bf16_t* Kh = Kg + rowbase * 1024 + h * 128; const bf16_t* Vh = Vg + rowbase * 1024 + h * 128;
    const bf16_t* ksrc0 = Kh + (size_t)lane * 1024 + wid * 8; const bf16_t* ksrc1 = ksrc0 + 64;
    const bf16_t* vsrc0 = Vh + (size_t)((wid & 3) * 16 + (lane >> 2)) * 1024 + (wid >> 2) * 32 + (lane & 3) * 8; const bf16_t* vsrc1 = vsrc0 + 64;
    const unsigned kd0 = wid * 1024, kd1 = (wid + 8) * 1024;
#define ATT_DMA(t, slot) do { const size_t _o = (size_t)(t) * 64 * 1024; \
        __builtin_amdgcn_global_load_lds((const unsigned*)(ksrc0 + _o), (LAS unsigned*)(lds + (slot) * SLOT + KOFF + kd0), 16, 0, 0); \
        __builtin_amdgcn_global_load_lds((const unsigned*)(ksrc1 + _o), (LAS unsigned*)(lds + (slot) * SLOT + KOFF + kd1), 16, 0, 0); \
        __builtin_amdgcn_global_load_lds((const unsigned*)(vsrc0 + _o), (LAS unsigned*)(lds + (slot) * SLOT + VOFF + kd0), 16, 0, 0); \
        __builtin_amdgcn_global_load_lds((const unsigned*)(vsrc1 + _o), (LAS unsigned*)(lds + (slot) * SLOT + VOFF + kd1), 16, 0, 0); } while (0)
    ATT_DMA(0, 0);
    const bf16_t* Qw = Qg + (rowbase + q0 + wq * 32 + r32) * 1024 + h * 128 + c * 64 + hi * 8;
    bf16x8 qr[4];
#pragma unroll
    for (int d0 = 0; d0 < 4; ++d0) qr[d0] = *(const bf16x8*)(Qw + d0 * 16);
    f32x16 o[4];
#pragma unroll
    for (int d = 0; d < 4; ++d)
#pragma unroll
        for (int r = 0; r < 16; ++r) o[d][r] = 0.f;
    float m_run = -1e30f, l_run = 0.f;
    LAS float* wsf = (LAS float*)(lds + WSF_OFF) + wid * 64;
    const int kro = (c * 8 + hi) * 1024 + r32 * 16;
    const int vro = (4 * hi + ((lane & 15) >> 2)) * 64 + ((lane >> 4) & 1) * 32 + (lane & 3) * 8;
    int slot = 0, nslot = 1;
    for (int t = 0; t < NT; ++t) {
        if (t + 1 < NT) { ATT_DMA(t + 1, nslot); asm volatile("s_waitcnt vmcnt(4)" ::: "memory"); }
        else asm volatile("s_waitcnt vmcnt(0)" ::: "memory");
        __builtin_amdgcn_s_barrier(); asm volatile("" ::: "memory");
        if (t < ntw) {
            const LAS unsigned char* Ks = lds + slot * SLOT + KOFF + kro; const LAS unsigned char* Vs = lds + slot * SLOT + VOFF + vro;
            f32x16 p0, p1;
#pragma unroll
            for (int r = 0; r < 16; ++r) { p0[r] = 0.f; p1[r] = 0.f; }
#pragma unroll
            for (int d0 = 0; d0 < 4; ++d0) { const bf16x8 k0 = *(const LAS bf16x8*)(Ks + d0 * 2048), k1 = *(const LAS bf16x8*)(Ks + d0 * 2048 + 512);
                p0 = __builtin_amdgcn_mfma_f32_32x32x16_bf16(k0, qr[d0], p0, 0, 0, 0); p1 = __builtin_amdgcn_mfma_f32_32x32x16_bf16(k1, qr[d0], p1, 0, 0, 0); }
            float mx = fmaxf(p0[0], p1[0]);
#pragma unroll
            for (int r = 1; r < 16; ++r) mx = fmaxf(mx, fmaxf(p0[r], p1[r]));
            mx = fmaxf(mx, __shfl_xor(mx, 32));
            const float m_new = fmaxf(m_run, mx), alpha = __builtin_amdgcn_exp2f(m_run - m_new); m_run = m_new;
            float ls = 0.f;
#pragma unroll
            for (int r = 0; r < 16; ++r) { p0[r] = __builtin_amdgcn_exp2f(p0[r] - m_new); p1[r] = __builtin_amdgcn_exp2f(p1[r] - m_new); ls += p0[r] + p1[r]; }
            l_run = l_run * alpha + ls;
            if (hi == 0) wsf[r32] = alpha;
#pragma unroll
            for (int g = 0; g < 4; ++g) { const f32x4 a4 = *(const LAS f32x4*)(wsf + 8 * g + 4 * hi);
#pragma unroll
                for (int d = 0; d < 4; ++d)
#pragma unroll
                    for (int k = 0; k < 4; ++k) o[d][4 * g + k] *= a4[k]; }
            bf16x8 pw[4];
#pragma unroll
            for (int s = 0; s < 2; ++s) { u32x4 w0, w1;
#pragma unroll
                for (int q = 0; q < 4; ++q) { w0[q] = pk2(p0[8 * s + 2 * q], p0[8 * s + 2 * q + 1]); w1[q] = pk2(p1[8 * s + 2 * q], p1[8 * s + 2 * q + 1]); }
                pw[s] = __builtin_bit_cast(bf16x8, w0); pw[2 + s] = __builtin_bit_cast(bf16x8, w1); }
#pragma unroll
            for (int d = 0; d < 4; ++d)
#pragma unroll
                for (int ks = 0; ks < 4; ++ks) { const s16x4 lo = vtr(Vs + d * 4096 + ks * 1024), hh = vtr(Vs + d * 4096 + ks * 1024 + 512);
                    const bf16x8 vf = (bf16x8){lo[0], lo[1], lo[2], lo[3], hh[0], hh[1], hh[2], hh[3]};
                    o[d] = __builtin_amdgcn_mfma_f32_32x32x16_bf16(pw[ks], vf, o[d], 0, 0, 0); }
        }
        slot = nslot; nslot = (nslot == 2) ? 0 : nslot + 1;
    }
    { const float lt = l_run + __shfl_xor(l_run, 32); const float inv = 1.0f / lt;
      if (hi == 0) wsf[r32] = inv;
#pragma unroll
      for (int g = 0; g < 4; ++g) { const f32x4 a4 = *(const LAS f32x4*)(wsf + 8 * g + 4 * hi);
#pragma unroll
          for (int d = 0; d < 4; ++d)
#pragma unroll
              for (int k = 0; k < 4; ++k) o[d][4 * g + k] *= a4[k]; } }
    asm volatile("s_waitcnt lgkmcnt(0)" ::: "memory"); __builtin_amdgcn_s_barrier(); asm volatile("" ::: "memory");
    LAS float* stg = (LAS float*)(lds + wq * STG_BYTES);
    if (c == 1) {
#pragma unroll
        for (int d = 0; d < 4; ++d)
#pragma unroll
            for (int r = 0; r < 16; ++r) stg[crow(r, hi) * STG_ROW + d * 32 + r32] = o[d][r];
    }
    asm volatile("s_waitcnt lgkmcnt(0)" ::: "memory"); __builtin_amdgcn_s_barrier(); asm volatile("" ::: "memory");
    if (c == 0) {
#pragma unroll
        for (int d = 0; d < 4; ++d)
#pragma unroll
            for (int r = 0; r < 16; ++r) { LAS float* p = stg + crow(r, hi) * STG_ROW + d * 32 + r32; *p = o[d][r] - lam * (*p); }
        asm volatile("s_waitcnt lgkmcnt(0)" ::: "memory");
        const int row = lane >> 1, hf = lane & 1; const LAS float* rp = stg + row * STG_ROW + hf * 64;
        f32x4 v[16]; float ss = 0.f;
#pragma unroll
        for (int i = 0; i < 16; ++i) { v[i] = *(const LAS f32x4*)(rp + 4 * i); ss += v[i][0] * v[i][0] + v[i][1] * v[i][1] + v[i][2] * v[i][2] + v[i][3] * v[i][3]; }
        ss += __shfl_xor(ss, 1);
        const float rs = (1.0f - LAM_INIT) / sqrtf(ss * (1.0f / 128.0f) + RMS_EPS);
        bf16_t* op = Og + (rowbase + q0 + wq * 32 + row) * 1024 + h * 128 + hf * 64; const float* gp = subln_g + hf * 64;
#pragma unroll
        for (int i = 0; i < 8; ++i) { const f32x4 ga = *(const f32x4*)(gp + 8 * i), gb = *(const f32x4*)(gp + 8 * i + 4); const f32x4 a = v[2 * i] * ga * rs, bq = v[2 * i + 1] * gb * rs;
            u32x4 w; w.x = pk2(a[0], a[1]); w.y = pk2(a[2], a[3]); w.z = pk2(bq[0], bq[1]); w.w = pk2(bq[2], bq[3]); *(u32x4*)(op + 8 * i) = w; }
    }
    asm volatile("s_waitcnt lgkmcnt(0)" ::: "memory"); __builtin_amdgcn_s_barrier(); asm volatile("" ::: "memory");
#undef ATT_DMA
}
}

namespace rg {
constexpr int CW_OFF = 0  , AGG_OFF = 2048  ;
__device__ __forceinline__ int crow(int r, int hi) { return (r & 3) + 8 * (r >> 2) + 4 * hi; }

__device__ __forceinline__ void rglru_unit(int b, int n, int hf, const bf16_t* XR, bf16_t* YG, const float* conv_w, const float* conv_b,
                                           const float* w_a, const float* b_a, const float* w_i, const float* b_i, const float* lam, LAS unsigned char* lds) {
    const int tid = threadIdx.x, lane = tid & 63, r32 = lane & 31, hi = lane >> 5; const int wid = __builtin_amdgcn_readfirstlane(tid >> 6);
    const int c0 = n * 64 + hf * 32, ch = c0 + r32;
    LAS float* cw = (LAS float*)(lds + CW_OFF);
    if (tid < 256) cw[tid] = conv_w[(tid >> 6) * 1024 + n * 64 + (tid & 63)]; else if (tid < 320) cw[tid] = conv_b[n * 64 + (tid - 256)];
    bf16x8 wa[4], wi[4], idm[2];
#pragma unroll
    for (int s = 0; s < 4; ++s) { u32x4 ua, ui;
#pragma unroll
        for (int q = 0; q < 4; ++q) { const size_t o0 = ((size_t)n * 64 + 16 * s + 8 * hi + 2 * q) * 64 + hf * 32 + r32;
            ua[q] = pk2(w_a[o0], w_a[o0 + 64]); ui[q] = pk2(w_i[o0], w_i[o0 + 64]); }
        wa[s] = __builtin_bit_cast(bf16x8, ua); wi[s] = __builtin_bit_cast(bf16x8, ui); }
#pragma unroll
    for (int s = 0; s < 2; ++s) { u32x4 ud;
#pragma unroll
        for (int q = 0; q < 4; ++q) { const int k0 = 16 * s + 8 * hi + 2 * q; ud[q] = (k0 == r32 ? 0x3f80u : 0u) | (k0 + 1 == r32 ? 0x3f800000u : 0u); }
        idm[s] = __builtin_bit_cast(bf16x8, ud); }
    const float ba = b_a[ch], bi = b_i[ch];
    const float lmb = lam[ch]; const float sp = (lmb < -20.f) ? -lmb : log1pf(expf(-lmb));
    const float nsp8 = -8.0f * sp * LOG2E;
    float carry = 0.f;
    const size_t rowbase = (size_t)b * SEQ;
    __syncthreads();
    for (int bt = 0; bt < SEQ / 256; ++bt) {
        const int t0 = bt * 256 + wid * 32;
        bf16x8 xa[4];
        int xo = (int)((rowbase + t0 + r32) * 1024 + n * 64 + 8 * hi); asm volatile("" : "+v"(xo));
#pragma unroll
        for (int s = 0; s < 4; ++s) { const int cl = 16 * s + 8 * hi; float v[8];
            { const f32x4 b0 = *(const LAS f32x4*)(cw + 256 + cl), b1 = *(const LAS f32x4*)(cw + 256 + cl + 4);
#pragma unroll
              for (int j = 0; j < 4; ++j) { v[j] = b0[j]; v[4 + j] = b1[j]; } }
#pragma unroll
            for (int tap = 0; tap < 4; ++tap) { const int tt = t0 + r32 - 3 + tap;
                u32x4 xv = *(const u32x4*)(XR + xo + (tap - 3) * 1024 + 16 * s);
                if (tt < 0) xv = (u32x4){0u, 0u, 0u, 0u};
                const f32x4 w0 = *(const LAS f32x4*)(cw + tap * 64 + cl), w1 = *(const LAS f32x4*)(cw + tap * 64 + cl + 4);
                v[0] += w0[0] * bf_lo(xv[0]); v[1] += w0[1] * bf_hi(xv[0]); v[2] += w0[2] * bf_lo(xv[1]); v[3] += w0[3] * bf_hi(xv[1]);
                v[4] += w1[0] * bf_lo(xv[2]); v[5] += w1[1] * bf_hi(xv[2]); v[6] += w1[2] * bf_lo(xv[3]); v[7] += w1[3] * bf_hi(xv[3]); }
            u32x4 pw; pw.x = pk2(v[0], v[1]); pw.y = pk2(v[2], v[3]); pw.z = pk2(v[4], v[5]); pw.w = pk2(v[6], v[7]); xa[s] = __builtin_bit_cast(bf16x8, pw); __builtin_amdgcn_sched_barrier(0); }
        bf16x8 ya[2];
        int yo = (int)((rowbase + t0 + r32) * 1024 + c0 + 8 * hi); asm volatile("" : "+v"(yo));
#pragma unroll
        for (int s = 0; s < 2; ++s) ya[s] = *(const bf16x8*)(YG + yo + 16 * s);
        f32x16 ga, gi, xc, yg;
#pragma unroll
        for (int r = 0; r < 16; ++r) { ga[r] = 0.f; gi[r] = 0.f; xc[r] = 0.f; yg[r] = 0.f; }
#pragma unroll
        for (int s = 0; s < 4; ++s) { ga = __builtin_amdgcn_mfma_f32_32x32x16_bf16(xa[s], wa[s], ga, 0, 0, 0); gi = __builtin_amdgcn_mfma_f32_32x32x16_bf16(xa[s], wi[s], gi, 0, 0, 0); }
        if (hf == 0) { xc = __builtin_amdgcn_mfma_f32_32x32x16_bf16(xa[0], idm[0], xc, 0, 0, 0); xc = __builtin_amdgcn_mfma_f32_32x32x16_bf16(xa[1], idm[1], xc, 0, 0, 0); }
        else         { xc = __builtin_amdgcn_mfma_f32_32x32x16_bf16(xa[2], idm[0], xc, 0, 0, 0); xc = __builtin_amdgcn_mfma_f32_32x32x16_bf16(xa[3], idm[1], xc, 0, 0, 0); }
        yg = __builtin_amdgcn_mfma_f32_32x32x16_bf16(ya[0], idm[0], yg, 0, 0, 0); yg = __builtin_amdgcn_mfma_f32_32x32x16_bf16(ya[1], idm[1], yg, 0, 0, 0);
        float a[16], u[16];
#pragma unroll
        for (int r = 0; r < 16; ++r) { const float rr = fast_sigmoid(ga[r] + ba), ii = fast_sigmoid(gi[r] + bi);
            const float av = __builtin_amdgcn_exp2f(nsp8 * rr); a[r] = av; u[r] = xc[r] * ii * __builtin_amdgcn_sqrtf(fmaxf(1.0f - av * av, 0.f)); if ((r & 3) == 3) __builtin_amdgcn_sched_barrier(0); }
        float mA[4], mB[4], oA[4], oB[4];
#pragma unroll
        for (int g = 0; g < 4; ++g) { float A = a[4 * g], Bv = u[4 * g];
#pragma unroll
            for (int k = 1; k < 4; ++k) { A *= a[4 * g + k]; Bv = Bv * a[4 * g + k] + u[4 * g + k]; }
            mA[g] = A; mB[g] = Bv; oA[g] = __shfl_xor(A, 32); oB[g] = __shfl_xor(Bv, 32); }
        __builtin_amdgcn_sched_barrier(0);
        float TA = 1.f, TB = 0.f;
#pragma unroll
        for (int g = 0; g < 4; ++g) { const float fA = hi ? oA[g] : mA[g], fB = hi ? oB[g] : mB[g], sA = hi ? mA[g] : oA[g], sB = hi ? mB[g] : oB[g];
            TB = TB * fA + fB; TA *= fA; TB = TB * sA + sB; TA *= sA; }
        LAS f32x2* agg = (LAS f32x2*)(lds + AGG_OFF) + (bt & 1) * 256;
        if (hi == 0) agg[wid * 32 + r32] = (f32x2){TA, TB};
        asm volatile("s_waitcnt lgkmcnt(0)" ::: "memory"); __builtin_amdgcn_s_barrier(); asm volatile("" ::: "memory");
        float hin = carry, hall = carry;
#pragma unroll
        for (int w = 0; w < 8; ++w) { const f32x2 ab = agg[w * 32 + r32]; hall = hall * ab[0] + ab[1]; if (w < wid) hin = hall; }
        carry = hall;
        float s = hin;
        int so = (int)((rowbase + t0 + 4 * hi) * 1024 + ch); asm volatile("" : "+v"(so));
#pragma unroll
        for (int g = 0; g < 4; ++g) { float st;
            if (hi) { s = s * oA[g] + oB[g]; st = s; s = s * mA[g] + mB[g]; } else { st = s; s = s * mA[g] + mB[g]; s = s * oA[g] + oB[g]; }
#pragma unroll
            for (int k = 0; k < 4; ++k) { st = st * a[4 * g + k] + u[4 * g + k];
                YG[so + (8 * g + k) * 1024] = (bf16_t)f2bf(st * yg[4 * g + k]); }
            __builtin_amdgcn_sched_barrier(0); }
    }
    __syncthreads();
}
}

constexpr int NWAVES = 8;
#ifndef MK_N_LAUNCHES
#define MK_N_LAUNCHES 1
#endif
constexpr int N_PHASES = 14;
constexpr int RING_OFF = 0, RING_BYTES = 131072;
constexpr int TAB_OFF = RING_BYTES;
constexpr int TAB_TP = TAB_OFF, TAB_CNT = TAB_OFF + 272, TAB_RT2E = TAB_OFF + 544, TAB_END = TAB_RT2E + 704;
constexpr int LDSCTL_OFF = RING_BYTES + 2048, MISC_OFF = LDSCTL_OFF + 320;
constexpr int LDS_BYTES = 147456;
static_assert(TAB_END <= LDSCTL_OFF && MISC_OFF + 128 <= LDS_BYTES, "LDS map");

typedef GAS unsigned gu32;
#define RLX_AGENT __ATOMIC_RELAXED, __HIP_MEMORY_SCOPE_AGENT
#define LDS_WAIT() asm volatile("s_waitcnt lgkmcnt(0)" ::: "memory")
#define VM_WAIT() asm volatile("s_waitcnt vmcnt(0)" ::: "memory")

#define XB_TMO      128
#define XB_XCNT(j)  (256  + 64 * (j))
#define XB_XSUB(j)  (1280 + 64 * (j))
#define XB_XGEN(j)  (2304 + 64 * (j))
#define XB_TOP      3328
#define XB_TOPGEN   3392
#define XCD_BAR_WORDS 3456
#define XB_SPIN_CAP (1u << 18)
__device__ __forceinline__ unsigned xb_ld(unsigned* p)              { return __hip_atomic_load(p, __ATOMIC_RELAXED, __HIP_MEMORY_SCOPE_AGENT); }
__device__ __forceinline__ unsigned xb_add(unsigned* p, unsigned v) { return __hip_atomic_fetch_add(p, v, __ATOMIC_RELAXED, __HIP_MEMORY_SCOPE_AGENT); }
__device__ __forceinline__ unsigned xb_xcc_id() { return (unsigned)__builtin_amdgcn_s_getreg((3 << 11) | 20) & 0xFu; }
#define XB_SPIN(cond, bar) do { unsigned _sp = 0; while (cond) { __builtin_amdgcn_s_sleep(1); \
    if ((++_sp & 255u) == 0u) { if (xb_ld(&(bar)[XB_TMO])) break; if (_sp > XB_SPIN_CAP) { atomicAdd(&(bar)[XB_TMO], 1u); break; } } } } while (0)
struct XcdBarrier { unsigned* bar; unsigned x; volatile LAS unsigned* st; };
__device__ __forceinline__ XcdBarrier xcd_barrier_post(unsigned* bar, volatile LAS unsigned* st) {
    XcdBarrier b; b.bar = bar; b.x = xb_xcc_id(); b.st = st;
    if (threadIdx.x == 0) (void)xb_add(&bar[XB_XCNT(b.x)], 1u);
    return b;
}
__device__ __forceinline__ void xcd_barrier_complete(unsigned* bar, unsigned x, unsigned& nloc, unsigned& nx) {
    const unsigned G = gridDim.x * gridDim.y * gridDim.z;
    unsigned sum, cnt, mine, sp = 0u;
    for (;;) {
        sum = 0u; cnt = 0u; mine = 0u;
#pragma unroll
        for (unsigned j = 0; j < 16; ++j) { const unsigned c = xb_ld(&bar[XB_XCNT(j)]); sum += c; cnt += (c > 0u) ? 1u : 0u; mine = (j == x) ? c : mine; }
        if (sum == G) break;
        __builtin_amdgcn_s_sleep(1);
        if ((++sp & 255u) == 0u) { if (xb_ld(&bar[XB_TMO])) break; if (sp > XB_SPIN_CAP) { atomicAdd(&bar[XB_TMO], 1u); break; } }
    }
    nloc = mine > 0u ? mine : 1u; nx = cnt > 0u ? cnt : 1u;
}
__device__ __forceinline__ void xcd_barrier(const XcdBarrier& b) {
    asm volatile("s_waitcnt vmcnt(0)" ::: "memory");
    __syncthreads();
    if (threadIdx.x == 0) {
        unsigned* bar = b.bar;
        __builtin_amdgcn_s_waitcnt(0);
        unsigned nloc = b.st[0], nx = b.st[1];
        if (nloc == 0u) { xcd_barrier_complete(bar, b.x, nloc, nx); b.st[0] = nloc; b.st[1] = nx; }
        const unsigned old = xb_add(&bar[XB_XSUB(b.x)], 1u);
        const unsigned gen = old / nloc;
        if (old + 1u == (gen + 1u) * nloc) {
            __builtin_amdgcn_fence(__ATOMIC_RELEASE, "agent");
            asm volatile("s_waitcnt vmcnt(0)" ::: "memory");
            const unsigned og = xb_add(&bar[XB_TOP], 1u);
            const unsigned tg = og / nx;
            if (og + 1u == (tg + 1u) * nx) xb_add(&bar[XB_TOPGEN], 1u);
            else XB_SPIN(xb_ld(&bar[XB_TOPGEN]) == tg, bar);
            __builtin_amdgcn_fence(__ATOMIC_ACQUIRE, "agent");
            xb_add(&bar[XB_XGEN(b.x)], 1u);
            asm volatile("s_waitcnt vmcnt(0)" ::: "memory");
        } else {
            XB_SPIN(xb_ld(&bar[XB_XGEN(b.x)]) == gen, bar);
            __builtin_amdgcn_fence(__ATOMIC_ACQUIRE, "agent");
            asm volatile("s_waitcnt vmcnt(0)" ::: "memory");
        }
    }
    __syncthreads();
}

struct Inputs {
    const float *x, *c, *w_ada, *b_ada, *w_in, *conv_w, *conv_b, *lru_w_a, *lru_b_a, *lru_w_i, *lru_b_i, *lru_lambda,
                *lam_q1, *lam_k1, *lam_q2, *lam_k2, *subln_g, *p_rnn, *p_attn, *w_out, *ln1_g, *ln1_b,
                *w_router, *router_bias, *we_gate, *we_up, *we_down, *ws_gate, *ws_up, *ws_down, *ln2_g, *ln2_b;
};
struct Args { Inputs in; float* out; unsigned char* ws; int ph_lo, ph_hi, li, pad; };

__device__ __forceinline__ float wave_sum(float v) {
#pragma unroll
    for (int o = 1; o < 64; o <<= 1) v += __shfl_xor(v, o);
    return v;
}

__device__ __forceinline__ void transpose_item(const float* W, int ldw, int k0, int n0, bf16_t* WT, size_t ldo, int orow0, int ocol0, LAS float* scr, int lane) {
#pragma unroll 8
    for (int i = 0; i < 32; ++i) { const int kk = 2 * i + (lane >> 5); scr[kk * 33 + (lane & 31)] = W[(size_t)(k0 + kk) * ldw + n0 + (lane & 31)]; }
    LDS_WAIT(); asm volatile("" ::: "memory");
    const int c = lane & 7;
#pragma unroll
    for (int j = 0; j < 4; ++j) { const int n = (lane >> 3) + 8 * j; const LAS float* s = scr + (8 * c) * 33 + n;
        u32x4 o; o.x = pk2(s[0 * 33], s[1 * 33]); o.y = pk2(s[2 * 33], s[3 * 33]); o.z = pk2(s[4 * 33], s[5 * 33]); o.w = pk2(s[6 * 33], s[7 * 33]);
        *(GAS u32x4*)(WT + (size_t)(orow0 + n) * ldo + ocol0 + k0 + 8 * c) = o; }
    LDS_WAIT(); asm volatile("" ::: "memory");
}

__global__ void __launch_bounds__(NWAVES * 64, 2) mk_fwd(Args args) {
    extern __shared__ __attribute__((aligned(16))) unsigned char lds_raw[];
    LAS unsigned char* lds = (LAS unsigned char*)lds_raw;
    volatile LAS unsigned* MISC = (volatile LAS unsigned*)(lds + MISC_OFF);
    const int tid = threadIdx.x, lane = tid & 63, wave = __builtin_amdgcn_readfirstlane(tid >> 6);
    const int G = gridDim.x; const int bx = blockIdx.x; const int vcu = (G % 8 == 0) ? (bx % 8) * (G / 8) + bx / 8 : bx;
    const int gw = vcu * NWAVES + wave, NGW = G * NWAVES;
    unsigned char* ws = args.ws; const Inputs& I = args.in;
    gu32* ctl = (gu32*)(ws + WS_CTL);
    float* ADA = (float*)(ws + WS_ADA);
    bf16_t* WIN = (bf16_t*)(ws + WS_WIN); bf16_t* WBR = (bf16_t*)(ws + WS_WBR); bf16_t* WOUT = (bf16_t*)(ws + WS_WOUT); bf16_t* WRTR = (bf16_t*)(ws + WS_WRTR);
    bf16_t* W1 = (bf16_t*)(ws + WS_W1); bf16_t* W2 = (bf16_t*)(ws + WS_W2);
    bf16_t* HB = (bf16_t*)(ws + WS_HB); bf16_t* XR = (bf16_t*)(ws + WS_XR); bf16_t* YG = (bf16_t*)(ws + WS_YG); bf16_t* QB = (bf16_t*)(ws + WS_Q);
    bf16_t* KB = (bf16_t*)(ws + WS_K); bf16_t* VB = (bf16_t*)(ws + WS_V); bf16_t* GB = (bf16_t*)(ws + WS_G); bf16_t* MRG = (bf16_t*)(ws + WS_XR);
    bf16_t* UB = (bf16_t*)(ws + WS_U); float* LOGITS = (float*)(ws + WS_LOG); unsigned* LIST = (unsigned*)(ws + WS_LIST); float* TOKW = (float*)(ws + WS_TOKW);
    bf16_t* HX = (bf16_t*)(ws + WS_H); bf16_t* YS = (bf16_t*)(ws + WS_Y);
    float* OUT = args.out;

    for (int u = tid; u < (LDS_BYTES - LDSCTL_OFF) / 4; u += NWAVES * 64) ((LAS unsigned*)(lds + LDSCTL_OFF))[u] = 0u;
    __syncthreads();
    XcdBarrier bar; bar.bar = (unsigned*)(ctl + CW_BAR); bar.x = 0; bar.st = nullptr;
    if (MK_N_LAUNCHES == 1) bar = xcd_barrier_post((unsigned*)(ctl + CW_BAR), MISC + 8);
    const int lo = args.ph_lo, hi = args.ph_hi;
#ifndef PH_MASK
#define PH_MASK 0xFFFF
#endif
#define IN(k) ((((PH_MASK) >> (k)) & 1) && lo <= (k) && (k) < hi)
#define SEAM(k) do { if (IN(k) && IN((k) + 1)) xcd_barrier(bar); } while (0)

    if (IN(0)) {
        if (vcu < 96) {
            LAS float* sc = (LAS float*)(lds + RING_OFF);
            LAS float* red = (LAS float*)(lds + RING_OFF + 32768);
            for (int i = tid; i < 8192; i += NWAVES * 64) { const int b = i >> 10, k = i & 1023; const float cv = I.c[i]; sc[k * 8 + b] = cv * fast_sigmoid(cv); }
            __syncthreads();
            float a8[8];
#pragma unroll
            for (int b = 0; b < 8; ++b) a8[b] = 0.f;
            const float* wp = I.w_ada + (size_t)(wave * 128) * 6144 + vcu * 64 + lane;
#pragma unroll 8
            for (int k = 0; k < 128; ++k) { const float w = wp[(size_t)k * 6144]; const f32x4 s0 = *(const LAS f32x4*)(sc + (wave * 128 + k) * 8), s1 = *(const LAS f32x4*)(sc + (wave * 128 + k) * 8 + 4);
                a8[0] += s0[0] * w; a8[1] += s0[1] * w; a8[2] += s0[2] * w; a8[3] += s0[3] * w; a8[4] += s1[0] * w; a8[5] += s1[1] * w; a8[6] += s1[2] * w; a8[7] += s1[3] * w; }
#pragma unroll
            for (int b = 0; b < 8; ++b) red[(wave * 8 + b) * 64 + lane] = a8[b];
            __syncthreads();
            { const int b = wave; float s = I.b_ada[vcu * 64 + lane];
#pragma unroll
              for (int w = 0; w < 8; ++w) s += red[(w * 8 + b) * 64 + lane];
              ADA[(size_t)b * 6144 + vcu * 64 + lane] = s; }
            __syncthreads();
        }
        LAS float* scr = (LAS float*)(lds + RING_OFF + wave * 16384);
        constexpr int I_IN = 16 * 224, I_SQ = 16 * 32, I_RT = 16 * 2, I_DN = 4 * 32;
        constexpr int NIT = I_IN + 3 * I_SQ + I_RT + NEXP1 * I_DN;
        for (int it = gw; it < NIT; it += NGW) {
            int r = it;
            if (r < I_IN) { transpose_item(I.w_in, DIN, 64 * (r / 224), 32 * (r % 224), WIN, 1024, 32 * (r % 224), 0, scr, lane); continue; } r -= I_IN;
            if (r < I_SQ) { transpose_item(I.p_rnn, 1024, 64 * (r / 32), 32 * (r % 32), WBR, 2048, 32 * (r % 32), 0, scr, lane); continue; } r -= I_SQ;
            if (r < I_SQ) { transpose_item(I.p_attn, 1024, 64 * (r / 32), 32 * (r % 32), WBR, 2048, 32 * (r % 32), 1024, scr, lane); continue; } r -= I_SQ;
            if (r < I_SQ) { transpose_item(I.w_out, 1024, 64 * (r / 32), 32 * (r % 32), WOUT, 1024, 32 * (r % 32), 0, scr, lane); continue; } r -= I_SQ;
            if (r < I_RT) { transpose_item(I.w_router, 64, 64 * (r / 2), 32 * (r % 2), WRTR, 1024, 32 * (r % 2), 0, scr, lane); continue; } r -= I_RT;
            { const int e = r / I_DN, q = r % I_DN; const float* src = (e < NEXP) ? I.we_down + (size_t)e * 256 * 1024 : I.ws_down;
              transpose_item(src, 1024, 64 * (q / 32), 32 * (q % 32), W2 + (size_t)e * 1024 * 256, 256, 32 * (q % 32), 0, scr, lane); }
        }
        for (int i = gw * 64 + lane; i < 192 * 1024 / 8; i += NGW * 64) *(u32x4*)(WRTR + 64 * 1024 + (size_t)i * 8) = (u32x4){0u, 0u, 0u, 0u};
    }
    SEAM(0);

    if (IN(1)) {
        for (int m = gw; m < M; m += NGW) {
            const float* ada = ADA + (size_t)(m / SEQ) * 6144;
            const GAS f32x4* xr = (const GAS f32x4*)(I.x + (size_t)m * DM) + lane;
            f32x4 v[4]; float s = 0.f;
#pragma unroll
            for (int j = 0; j < 4; ++j) { v[j] = xr[64 * j]; s += (v[j].x + v[j].y) + (v[j].z + v[j].w); }
            const float mean = wave_sum(s) * (1.f / DM); float s2 = 0.f;
#pragma unroll
            for (int j = 0; j < 4; ++j) { v[j] = v[j] - mean; s2 += (v[j].x * v[j].x + v[j].y * v[j].y) + (v[j].z * v[j].z + v[j].w * v[j].w); }
            const float rstd = 1.f / sqrtf(wave_sum(s2) * (1.f / DM) + LN_EPS);
            GAS u32x2* o8 = (GAS u32x2*)(HB + (size_t)m * DM) + lane;
#pragma unroll
            for (int j = 0; j < 4; ++j) { const f32x4 sh = *((const f32x4*)ada + lane + 64 * j), sc = *((const f32x4*)(ada + 1024) + lane + 64 * j);
                const f32x4 y = v[j] * rstd * (sc + 1.0f) + sh; o8[64 * j] = (u32x2){pk2(y.x, y.y), pk2(y.z, y.w)}; }
        }
    }
    SEAM(1);

    if (IN(2)) {
        pg8::Gemm g{HB, WIN, 1024, 1 << 30, 0}; pg8::DenseSched S; S.init(M, DIN, 1024, G, bx, 2048u);
        pg8::EpiInProj E{XR, YG, QB, KB, VB, GB};
        pg8::gemm_phase<pg8::EpiInProj, pg8::DenseSched, true>(lds + RING_OFF, g, S, E);
    }
    SEAM(2);

    if (IN(3)) {
        for (int u = vcu; u < 256; u += G) rg::rglru_unit(u >> 5, (u >> 1) & 15, u & 1, XR, YG, I.conv_w, I.conv_b, I.lru_w_a, I.lru_b_a, I.lru_w_i, I.lru_b_i, I.lru_lambda, lds + RING_OFF);
        const float s1 = wave_sum(I.lam_q1[lane] * I.lam_k1[lane]), s2 = wave_sum(I.lam_q2[lane] * I.lam_k2[lane]);
        const float lam = expf(s1) - expf(s2) + LAM_INIT;
        for (int v = vcu; v < 256; v += G) { const int bh = v >> 2, j = v & 3;
#pragma unroll 1
            for (int i = 0; i < 4; ++i) { const int qb = (i == 0) ? 15 - j : (i == 1) ? 8 + j : (i == 2) ? 7 - j : j;
                att::attn_unit(bh >> 3, bh & 7, qb, QB, KB, VB, QB, lds + RING_OFF, lam, I.subln_g); } }
    }
    SEAM(3);

    if (IN(4)) {
        pg8::Gemm g{YG, WBR, 2048, 16, (long)(WS_Q - WS_YG) - 16 * 128}; pg8::DenseSched S; S.init(M, 1024, 2048, G, bx, 2048u);
        pg8::EpiBranch E{GB, MRG};
        pg8::gemm_phase<pg8::EpiBranch, pg8::DenseSched, true>(lds + RING_OFF, g, S, E);
    }
    SEAM(4);

    if (IN(5)) {
        pg8::Gemm g{MRG, WOUT, 1024, 1 << 30, 0}; pg8::DenseSched S; S.init(M, 1024, 1024, G, bx, 2048u);
        pg8::EpiOutProj E{I.x, ADA, OUT};
        pg8::gemm_phase<pg8::EpiOutProj, pg8::DenseSched, true>(lds + RING_OFF, g, S, E);
    }
    SEAM(5);

    if (IN(6)) {
        for (int m = gw; m < M; m += NGW) {
            const float* ada = ADA + (size_t)(m / SEQ) * 6144;
            GAS f32x4* xr = (GAS f32x4*)(OUT + (size_t)m * DM) + lane;
            f32x4 v[4]; float s = 0.f;
#pragma unroll
            for (int j = 0; j < 4; ++j) { v[j] = xr[64 * j]; s += (v[j].x + v[j].y) + (v[j].z + v[j].w); }
            float mean = wave_sum(s) * (1.f / DM), s2 = 0.f;
#pragma unroll
            for (int j = 0; j < 4; ++j) { v[j] = v[j] - mean; s2 += (v[j].x * v[j].x + v[j].y * v[j].y) + (v[j].z * v[j].z + v[j].w * v[j].w); }
            float rstd = 1.f / sqrtf(wave_sum(s2) * (1.f / DM) + LN_EPS);
            s = 0.f;
#pragma unroll
            for (int j = 0; j < 4; ++j) { const f32x4 gg = *((const f32x4*)I.ln1_g + lane + 64 * j), bb = *((const f32x4*)I.ln1_b + lane + 64 * j);
                v[j] = v[j] * rstd * gg + bb; xr[64 * j] = v[j]; s += (v[j].x + v[j].y) + (v[j].z + v[j].w); }
            mean = wave_sum(s) * (1.f / DM); s2 = 0.f;
#pragma unroll
            for (int j = 0; j < 4; ++j) { v[j] = v[j] - mean; s2 += (v[j].x * v[j].x + v[j].y * v[j].y) + (v[j].z * v[j].z + v[j].w * v[j].w); }
            rstd = 1.f / sqrtf(wave_sum(s2) * (1.f / DM) + LN_EPS);
            GAS u32x2* o8 = (GAS u32x2*)(UB + (size_t)m * DM) + lane;
#pragma unroll
            for (int j = 0; j < 4; ++j) { const f32x4 sh = *((const f32x4*)(ada + 3072) + lane + 64 * j), sc = *((const f32x4*)(ada + 4096) + lane + 64 * j);
                const f32x4 y = v[j] * rstd * (sc + 1.0f) + sh; o8[64 * j] = (u32x2){pk2(y.x, y.y), pk2(y.z, y.w)}; }
        }
    }
    SEAM(6);

    if (IN(7)) {
        { pg8::Gemm g{UB, WRTR, 1024, 1 << 30, 0}; pg8::DenseSched S; S.init(M, 256, 1024, G, bx, 2048u);
          pg8::EpiRouter E{LOGITS};
          pg8::gemm_phase<pg8::EpiRouter, pg8::DenseSched, true>(lds + RING_OFF, g, S, E); }
        __syncthreads();
        LAS float* scr = (LAS float*)(lds + RING_OFF + wave * 16384);
        constexpr int I_GU = 16 * 8, NIT = NEXP1 * 2 * I_GU;
        for (int it = gw; it < NIT; it += NGW) { const int e = it / (2 * I_GU), r = it % (2 * I_GU), up = r / I_GU, q = r % I_GU, n0 = 32 * (q % 8);
            const float* src = (e < NEXP) ? (up ? I.we_up : I.we_gate) + (size_t)e * 1024 * 256 : (up ? I.ws_up : I.ws_gate);
            transpose_item(src, 256, 64 * (q / 8), n0, W1 + (size_t)e * 512 * 1024, 1024, (n0 >> 7) * 256 + up * 128 + (n0 & 127), 0, scr, lane); }
    }
    SEAM(7);

    if (IN(8)) {
        LAS float* sl = (LAS float*)(lds + RING_OFF);
        LAS float* sv = sl + 64 * 65;
        LAS unsigned* hist = (LAS unsigned*)(sv + 64 * 65);
        LAS unsigned* base = hist + 64;
        for (int tg = vcu; tg < M / 64; tg += G) {
            for (int i = tid; i < 64 * 64; i += NWAVES * 64) { const int t = i >> 6, e = i & 63; const float s = fast_sigmoid(LOGITS[(size_t)(tg * 64 + t) * 64 + e]); sv[t * 65 + e] = s; sl[t * 65 + e] = s + I.router_bias[e]; }
            if (tid < 64) hist[tid] = 0u;
            __syncthreads();
            if (wave == 0) {
                const LAS float* ms = sl + lane * 65; const LAS float* mv = sv + lane * 65;
                float gs[8];
#pragma unroll
                for (int g = 0; g < 8; ++g) { float t1 = -INFINITY, t2 = -INFINITY;
#pragma unroll
                    for (int j = 0; j < 8; ++j) { const float x = ms[g * 8 + j]; if (x > t1) { t2 = t1; t1 = x; } else if (x > t2) t2 = x; }
                    gs[g] = t1 + t2; }
                unsigned gmask = 0u;
#pragma unroll
                for (int r = 0; r < 4; ++r) { float best = -INFINITY; int bi = 0;
#pragma unroll
                    for (int g = 0; g < 8; ++g) { const bool ok = !((gmask >> g) & 1u) && gs[g] > best; best = ok ? gs[g] : best; bi = ok ? g : bi; }
                    gmask |= 1u << bi; }
                unsigned long long picked = 0ull; int ei[8]; float wv[8]; float wsum = 0.f;
#pragma unroll
                for (int r = 0; r < 8; ++r) { float best = -INFINITY; int bi = 0;
                    for (int e = 0; e < 64; ++e) { const float x = ms[e]; const bool ok = ((gmask >> (e >> 3)) & 1u) && !((picked >> e) & 1ull) && x > best; best = ok ? x : best; bi = ok ? e : bi; }
                    picked |= 1ull << bi; ei[r] = bi; wv[r] = mv[bi]; wsum += wv[r]; }
                const float wn = 2.5f / wsum; const unsigned tok = (unsigned)(tg * 64 + lane); unsigned pos[8];
#pragma unroll
                for (int r = 0; r < 8; ++r) { pos[r] = atomicAdd((unsigned*)&hist[ei[r]], 1u); TOKW[(size_t)tok * 8 + r] = wv[r] * wn; }
                LDS_WAIT();
                { const unsigned hc = hist[lane]; base[lane] = hc ? __hip_atomic_fetch_add(ctl + CW_CNT + 64 * lane, hc, RLX_AGENT) : 0u; }
                LDS_WAIT();
#pragma unroll
                for (int r = 0; r < 8; ++r) LIST[(size_t)ei[r] * M + base[ei[r]] + pos[r]] = tok * 16u + (unsigned)r;
            }
            __syncthreads();
        }
    }
    SEAM(8);

    pg8::ExpertTables ET; ET.tp = (const LAS int*)(lds + TAB_TP); ET.cnt = (const LAS int*)(lds + TAB_CNT); ET.rt2e = (const LAS unsigned char*)(lds + TAB_RT2E); ET.RT = 0;
    if (hi > 9) {
        LAS int* tp = (LAS int*)(lds + TAB_TP); LAS int* cn = (LAS int*)(lds + TAB_CNT); LAS unsigned char* r2e = (LAS unsigned char*)(lds + TAB_RT2E);
        if (tid < NEXP1) cn[tid] = (tid < NEXP) ? (int)__hip_atomic_load(ctl + CW_CNT + 64 * tid, RLX_AGENT) : M;
        __syncthreads();
        if (tid == 0) { int acc = 0; for (int e = 0; e < NEXP1; ++e) { tp[e] = acc; acc += (cn[e] + 255) >> 8; } tp[NEXP1] = acc; }
        __syncthreads();
        const int RT = tp[NEXP1];
        for (int e = wave; e < NEXP1; e += NWAVES) for (int rt = tp[e] + lane; rt < tp[e + 1]; rt += 64) r2e[rt] = (unsigned char)e;
        __syncthreads();
        ET.RT = RT;
    }

    if (IN(9)) {
        pg8::Gemm g{UB, W1, 1024, 1 << 30, 0};
        pg8::ExpertSched S; S.T = ET; S.nN = 2; S.G = G; S.c = bx; S.list = LIST; S.mode = 0; S.bstride = W1_STRIDE; S.bsub = 256 * 1024 * 2; S.pn0 = 0;
        pg8::EpiGemm1 E{ET, LIST, TOKW, HX};
        pg8::gemm_phase<pg8::EpiGemm1, pg8::ExpertSched, true>(lds + RING_OFF, g, S, E);
    }
    SEAM(9);

#pragma unroll 1
    for (int half = 0; half < 2; ++half) {
        if (IN(10 + 2 * half)) {
            pg8::Gemm g{HX, W2, 256, 1 << 30, 0};
            pg8::ExpertSched S; S.T = ET; S.nN = 2; S.G = G; S.c = bx; S.list = LIST; S.mode = 1; S.bstride = W2_STRIDE; S.bsub = 256 * 256 * 2; S.pn0 = 2 * half;
            pg8::EpiGemm2 E{LIST, YS};
            pg8::gemm_phase<pg8::EpiGemm2, pg8::ExpertSched, true>(lds + RING_OFF, g, S, E);
        }
        SEAM(10 + 2 * half);
        if (IN(11 + 2 * half)) {
            for (int m = gw; m < M; m += NGW) {
                const float* ada = ADA + (size_t)(m / SEQ) * 6144;
                float a[8];
#pragma unroll
                for (int j = 0; j < 8; ++j) a[j] = 0.f;
#pragma unroll
                for (int k = 0; k < NSLOTK; ++k) { const u32x4 y = *(const u32x4*)(YS + ((size_t)m * NSLOTK + k) * 512 + lane * 8);
#pragma unroll
                    for (int q = 0; q < 4; ++q) { a[2 * q] += bf_lo(y[q]); a[2 * q + 1] += bf_hi(y[q]); } }
                float* op = OUT + (size_t)m * DM + half * 512 + lane * 8; const float* g2 = ada + 5120 + half * 512 + lane * 8;
                f32x4 x0 = *(const f32x4*)op, x1 = *(const f32x4*)(op + 4); const f32x4 ga = *(const f32x4*)g2, gb = *(const f32x4*)(g2 + 4);
                x0 = x0 * ALPHA_DN + ga * (f32x4){a[0], a[1], a[2], a[3]}; x1 = x1 * ALPHA_DN + gb * (f32x4){a[4], a[5], a[6], a[7]};
                if (half == 0) { *(f32x4*)op = x0; *(f32x4*)(op + 4) = x1; }
                else { const float* pp = OUT + (size_t)m * DM + lane * 8; f32x4 p0 = *(const f32x4*)pp, p1 = *(const f32x4*)(pp + 4);
                    float s = (p0.x + p0.y) + (p0.z + p0.w) + (p1.x + p1.y) + (p1.z + p1.w) + (x0.x + x0.y) + (x0.z + x0.w) + (x1.x + x1.y) + (x1.z + x1.w);
                    const float mean = wave_sum(s) * (1.f / DM); p0 = p0 - mean; p1 = p1 - mean; x0 = x0 - mean; x1 = x1 - mean;
                    float s2 = (p0.x * p0.x + p0.y * p0.y) + (p0.z * p0.z + p0.w * p0.w) + (p1.x * p1.x + p1.y * p1.y) + (p1.z * p1.z + p1.w * p1.w)
                             + (x0.x * x0.x + x0.y * x0.y) + (x0.z * x0.z + x0.w * x0.w) + (x1.x * x1.x + x1.y * x1.y) + (x1.z * x1.z + x1.w * x1.w);
                    const float rstd = 1.f / sqrtf(wave_sum(s2) * (1.f / DM) + LN_EPS);
                    const float* lg = I.ln2_g + lane * 8; const float* lb = I.ln2_b + lane * 8;
                    *(f32x4*)pp = p0 * rstd * *(const f32x4*)lg + *(const f32x4*)lb; *(f32x4*)(pp + 4) = p1 * rstd * *(const f32x4*)(lg + 4) + *(const f32x4*)(lb + 4);
                    *(f32x4*)op = x0 * rstd * *(const f32x4*)(lg + 512) + *(const f32x4*)(lb + 512); *(f32x4*)(op + 4) = x1 * rstd * *(const f32x4*)(lg + 516) + *(const f32x4*)(lb + 516); }
            }
        }
        if (half == 0) SEAM(11);
    }
#undef IN
#undef SEAM
}

extern "C" void kernel_launch(void* const* d_in, const int* in_sizes, int n_in, void* d_out, int out_size, void* d_ws, size_t ws_size, hipStream_t stream) {
    static int grid = 0;
    if (grid == 0) {
        if (n_in != 32 || in_sizes[0] != M * DM || out_size != M * DM || ws_size < WS_END) { fprintf(stderr, "kernel_launch: unexpected shapes / workspace (n_in %d, ws %zu < %zu); nothing launched\n", n_in, ws_size, (size_t)WS_END); grid = -1; return; }
        int dev = 0, cus = 0, per_cu = 0;
        if (hipGetDevice(&dev) != hipSuccess || hipDeviceGetAttribute(&cus, hipDeviceAttributeMultiprocessorCount, dev) != hipSuccess) { grid = -1; return; }
        if (hipFuncSetAttribute((const void*)mk_fwd, hipFuncAttributeMaxDynamicSharedMemorySize, LDS_BYTES) != hipSuccess) { fprintf(stderr, "kernel_launch: hipFuncSetAttribute failed\n"); grid = -1; return; }
        if (hipOccupancyMaxActiveBlocksPerMultiprocessor(&per_cu, (const void*)mk_fwd, NWAVES * 64, LDS_BYTES) != hipSuccess || per_cu < 1) { fprintf(stderr, "kernel_launch: occupancy query reports %d\n", per_cu); }
        (void)hipGetLastError();
        grid = cus;
    }
    if (grid < 0) return;
    (void)hipMemsetAsync((char*)d_ws + WS_CTL, 0, CTL_ZERO_BYTES, stream);
    Args a{};
    const float** ip = (const float**)&a.in;
    for (int i = 0; i < 32; ++i) ip[i] = (const float*)d_in[i];
    a.out = (float*)d_out; a.ws = (unsigned char*)d_ws;
    if (MK_N_LAUNCHES == 1) { a.ph_lo = 0; a.ph_hi = N_PHASES; a.li = 0; hipLaunchKernelGGL(mk_fwd, dim3(grid), dim3(NWAVES * 64), LDS_BYTES, stream, a); }
    else for (int p = 0; p < N_PHASES; ++p) { a.ph_lo = p; a.ph_hi = p + 1; a.li = p; hipLaunchKernelGGL(mk_fwd, dim3(grid), dim3(NWAVES * 64), LDS_BYTES, stream, a); }
}
```

```cpp
#define MK_N_LAUNCHES 1
#include <hip/hip_runtime.h>
#include <cstdio>
#include <cstdint>

#define LAS __attribute__((address_space(3)))
#define GAS __attribute__((address_space(1)))
typedef unsigned short bf16_t;
typedef short bf16x8 __attribute__((ext_vector_type(8)));
typedef short s16x4 __attribute__((ext_vector_type(4)));
typedef float f32x4 __attribute__((ext_vector_type(4)));
typedef float f32x2 __attribute__((ext_vector_type(2)));
typedef float f32x16 __attribute__((ext_vector_type(16)));
typedef unsigned u32x4 __attribute__((ext_vector_type(4)));
typedef unsigned u32x2 __attribute__((ext_vector_type(2)));

constexpr int BATCH = 8, SEQ = 2048, DM = 1024, M = BATCH * SEQ, DIN = 7168;
constexpr int NEXP = 64, NEXP1 = 65  , TOPK = 8, DEXP = 256, NSLOTK = 9  ;
constexpr float ALPHA_DN = 1.189207115002721f;
constexpr float LN_EPS = 1e-5f, RMS_EPS = 1e-5f;
constexpr float LOG2E = 1.4426950408889634f;
constexpr float QSCALE = 0.125f * LOG2E;
constexpr float LAM_INIT = 0.2f;

__device__ __forceinline__ unsigned f2bf(float f) { unsigned u = __builtin_bit_cast(unsigned, f); return (u + 0x7fffu + ((u >> 16) & 1u)) >> 16; }
__device__ __forceinline__ unsigned pk2(float lo, float hi) { return f2bf(lo) | (f2bf(hi) << 16); }
__device__ __forceinline__ float bf_lo(unsigned w) { return __builtin_bit_cast(float, w << 16); }
__device__ __forceinline__ float bf_hi(unsigned w) { return __builtin_bit_cast(float, w & 0xffff0000u); }
__device__ __forceinline__ float fast_sigmoid(float x) { return __builtin_amdgcn_rcpf(1.0f + __builtin_amdgcn_exp2f(-x * LOG2E)); }
__device__ __forceinline__ float gelu_tanh(float x) { const float z = 1.5957691216057308f * (x + 0.044715f * x * x * x); return x * __builtin_amdgcn_rcpf(1.0f + __builtin_amdgcn_exp2f(-z * LOG2E)); }

namespace pg8 {
constexpr int BM = 256, BK = 64, HALF = 128, HTB = HALF * BK * 2  , STAGE_BYTES = 8 * HTB, NXCD = 8, WGM = 8;

__host__ __device__ __forceinline__ int lds_byte(int r, int c) { const int st = (r >> 4) * 2 + (c >> 5), rr = r & 15, cc = c & 31, ob = rr * 64 + cc * 2; return st * 1024 + (ob ^ (((ob >> 9) & 1) << 5)); }
__host__ __device__ __forceinline__ void stage_rc(int b, int& R, int& C) { const int st = b / 1024, sb = b % 1024, swz = sb ^ (((sb >> 9) & 1) << 5); R = (st >> 1) * 16 + swz / 64; C = (st & 1) * 32 + (swz % 64) / 2; }
__host__ __device__ __forceinline__ int perm32(int rho) { const int n = rho >> 4, i = rho & 15; return 8 * (i >> 2) + 4 * n + (i & 3); }

struct Unit { int pm, pn, e, nrows; };
struct Gemm { const bf16_t* A; const bf16_t* Bt; int K; int ksplit; long a2delta; };

template <class Epi, class Sched, bool ALIGN_EPI>
__device__ __forceinline__ void gemm_phase(LAS unsigned char* lds, const Gemm g, const Sched& S, const Epi& E) {
    const int tid = threadIdx.x, wid = __builtin_amdgcn_readfirstlane(tid >> 6), lane = tid & 63, wr = wid >> 2, wc = wid & 3, fr = lane & 15, fq = lane >> 4;
    const int K = g.K, nt = K / BK;
    int RA[2]; unsigned CA[2], voffB[2];
#pragma unroll
    for (int i = 0; i < 2; ++i) { int R, C; stage_rc(tid * 16 + i * 8192, R, C); const int Rb = (R & ~31) + perm32(R & 31);
        RA[i] = R; CA[i] = (unsigned)C * 2u; voffB[i] = (unsigned)(Rb * K + C) * 2u; }
    const size_t kstep = (size_t)(BK * 2);
    const size_t hstepB = (size_t)HALF * K * 2;
    const unsigned ldsw = (unsigned)wid * 1024u;
    const int aoff = lds_byte(wr * 64 + fr, fq * 8), boff = lds_byte(wc * 32 + fr, fq * 8);
#define PG8_SA(b, h) (((b) * 2 + (h)) * HTB)
#define PG8_SB(b, h) ((4 + (b) * 2 + (h)) * HTB)
#define PG8_STAGE_B(bufoff, gbase) do { _Pragma("unroll") for (int _i = 0; _i < 2; ++_i) \
        __builtin_amdgcn_global_load_lds((const unsigned*)((const char*)(gbase) + voffB[_i]), (LAS unsigned*)(lds + (bufoff) + ldsw + _i * 8192), 16, 0, 0); } while (0)
#define PG8_STAGE_A(bufoff, gbase, offs) do { _Pragma("unroll") for (int _i = 0; _i < 2; ++_i) \
        __builtin_amdgcn_global_load_lds((const unsigned*)((const char*)(gbase) + (offs)[_i]), (LAS unsigned*)(lds + (bufoff) + ldsw + _i * 8192), 16, 0, 0); } while (0)
#define PG8_LDA(dst, b, h) do { _Pragma("unroll") for (int m = 0; m < 4; ++m) _Pragma("unroll") for (int k = 0; k < 2; ++k) dst[m][k] = *(const LAS bf16x8*)(lds + PG8_SA(b, h) + aoff + m * 2048 + k * 1024); } while (0)
#define PG8_LDB(dst, b, h) do { _Pragma("unroll") for (int n = 0; n < 2; ++n) _Pragma("unroll") for (int k = 0; k < 2; ++k) dst[n][k] = *(const LAS bf16x8*)(lds + PG8_SB(b, h) + boff + n * 2048 + k * 1024); } while (0)
#define PG8_MMA(ai, bj, At, Bt) do { __builtin_amdgcn_s_setprio(1); _Pragma("unroll") for (int m = 0; m < 4; ++m) _Pragma("unroll") for (int n = 0; n < 2; ++n) _Pragma("unroll") for (int k = 0; k < 2; ++k) \
        acc[ai][bj][m][n] = __builtin_amdgcn_mfma_f32_16x16x32_bf16(Bt[n][k], At[m][k], acc[ai][bj][m][n], 0, 0, 0); __builtin_amdgcn_s_setprio(0); } while (0)
#define PG8_WAIT_V(n) asm volatile("s_waitcnt vmcnt(" #n ")" ::: "memory")
#define PG8_WAIT_L(n) asm volatile("s_waitcnt lgkmcnt(" #n ")" ::: "memory")
#define PG8_BAR __builtin_amdgcn_s_barrier()
#define PG8_SCHED __builtin_amdgcn_sched_barrier(0)
    Unit cur, nxt; int ui = 0;
    if (!S.next(0, cur)) return;
    unsigned so0[2], so1[2], no0[2], no1[2];
#pragma unroll
    for (int i = 0; i < 2; ++i) { so0[i] = S.a_off(cur, RA[i]) + CA[i]; so1[i] = S.a_off(cur, HALF + RA[i]) + CA[i]; }
    f32x4 acc[2][2][4][2];
#pragma unroll
    for (int a = 0; a < 2; ++a)
#pragma unroll
        for (int b = 0; b < 2; ++b)
#pragma unroll
            for (int m = 0; m < 4; ++m)
#pragma unroll
                for (int n = 0; n < 2; ++n) acc[a][b][m][n] = (f32x4){0.f, 0.f, 0.f, 0.f};
    bf16x8 At[4][2], B0[2][2], B1[2][2];
    const char* Ab = (const char*)g.A;
    const int ksplit = g.ksplit; const long a2d = g.a2delta;
#define PG8_KA(tt) (Ab + (size_t)(tt) * kstep + ((tt) >= ksplit ? a2d : 0l))
    const char* cB = (const char*)g.Bt + S.b_off(cur);
    { const char* a0 = PG8_KA(0); const char* a1 = PG8_KA(1);
      PG8_STAGE_B(PG8_SB(0, 0), cB); PG8_STAGE_B(PG8_SB(0, 1), cB + hstepB); PG8_STAGE_A(PG8_SA(0, 0), a0, so0); PG8_STAGE_A(PG8_SA(0, 1), a0, so1);
      if (wr == 1) PG8_BAR;
      PG8_WAIT_V(2); PG8_BAR;
      PG8_STAGE_B(PG8_SB(1, 0), cB + kstep); PG8_STAGE_A(PG8_SA(1, 0), a1, so0); PG8_STAGE_B(PG8_SB(1, 1), cB + hstepB + kstep);
      PG8_WAIT_V(6); PG8_BAR; }
    for (;;) {
        const bool has_next = S.next(ui + 1, nxt);
        if (has_next) {
#pragma unroll
            for (int i = 0; i < 2; ++i) { no0[i] = S.a_off(nxt, RA[i]) + CA[i]; no1[i] = S.a_off(nxt, HALF + RA[i]) + CA[i]; }
        } else {
#pragma unroll
            for (int i = 0; i < 2; ++i) { no0[i] = so0[i]; no1[i] = so1[i]; }
        }
        const char* nB = has_next ? (const char*)g.Bt + S.b_off(nxt) : cB;
        for (int t = 0; t < nt; t += 2) {
            const bool last = (t == nt - 2);
            if constexpr (Epi::HAS_MID) { if (t == (nt >> 1)) E.mid(acc, cur, wr, wc, fr, fq); }
            const char* a1 = PG8_KA(t + 1);
            const int t2 = last ? 0 : t + 2;
            const char* a2 = PG8_KA(t2); const char* a3 = PG8_KA(t2 + 1);
            const char* b2 = last ? nB : cB + (size_t)(t + 2) * kstep; const char* b3 = b2 + kstep;
            PG8_LDB(B0, 0, 0); PG8_LDB(B1, 0, 1); PG8_SCHED; PG8_LDA(At, 0, 0); PG8_STAGE_A(PG8_SA(1, 1), a1, so1);
            if (last) {
#pragma unroll
                for (int i = 0; i < 2; ++i) { so0[i] = no0[i]; so1[i] = no1[i]; }
            }
            PG8_WAIT_V(8); PG8_WAIT_L(0); PG8_BAR; PG8_MMA(0, 0, At, B0); PG8_MMA(0, 1, At, B1); PG8_BAR; PG8_SCHED;
            PG8_LDA(At, 0, 1); PG8_STAGE_B(PG8_SB(0, 0), b2); PG8_STAGE_B(PG8_SB(0, 1), b2 + hstepB); PG8_STAGE_A(PG8_SA(0, 0), a2, so0);
            PG8_WAIT_V(8); PG8_WAIT_L(0); PG8_BAR; PG8_MMA(1, 0, At, B0); PG8_MMA(1, 1, At, B1); PG8_BAR; PG8_SCHED;
            PG8_LDB(B0, 1, 0); PG8_LDB(B1, 1, 1); PG8_SCHED; PG8_LDA(At, 1, 0); PG8_STAGE_A(PG8_SA(0, 1), a2, so1);
            PG8_WAIT_V(8); PG8_WAIT_L(0); PG8_BAR; PG8_MMA(0, 0, At, B0); PG8_MMA(0, 1, At, B1); PG8_BAR; PG8_SCHED;
            PG8_LDA(At, 1, 1); PG8_STAGE_B(PG8_SB(1, 0), b3); PG8_STAGE_B(PG8_SB(1, 1), b3 + hstepB); PG8_STAGE_A(PG8_SA(1, 0), a3, so0);
            PG8_WAIT_V(8); PG8_WAIT_L(0); PG8_BAR; PG8_MMA(1, 0, At, B0); PG8_MMA(1, 1, At, B1); PG8_BAR; PG8_SCHED;
        }
        if constexpr (ALIGN_EPI) { if (wr == 0) PG8_BAR; }
        E(acc, cur, wr, wc, fr, fq);
        if (!has_next) break;
#pragma unroll
        for (int a = 0; a < 2; ++a)
#pragma unroll
            for (int b = 0; b < 2; ++b)
#pragma unroll
                for (int m = 0; m < 4; ++m)
#pragma unroll
                    for (int n = 0; n < 2; ++n) acc[a][b][m][n] = (f32x4){0.f, 0.f, 0.f, 0.f};
        cur = nxt; cB = nB; ++ui;
        if constexpr (ALIGN_EPI) { if (wr == 1) PG8_BAR; }
    }
    PG8_WAIT_V(0);
    if constexpr (!ALIGN_EPI) { if (wr == 0) PG8_BAR; }
    PG8_BAR;
#undef PG8_SA
#undef PG8_SB
#undef PG8_STAGE_A
#undef PG8_STAGE_B
#undef PG8_LDA
#undef PG8_LDB
#undef PG8_MMA
#undef PG8_WAIT_V
#undef PG8_WAIT_L
#undef PG8_BAR
#undef PG8_SCHED
#undef PG8_KA
}

struct DenseSched {
    int nM, nN, nwg, G, c; unsigned lda_bytes; int Kb;
    __device__ void init(int M_, int N_, int K_, int G_, int c_, unsigned lda_bytes_) { nM = M_ / BM; nN = N_ / BM; nwg = nM * nN; G = G_; c = c_; lda_bytes = lda_bytes_; Kb = K_ * 2; }
    __device__ __forceinline__ bool next(int i, Unit& u) const {
        const long L = (long)i * G + c; if (L >= nwg) return false;
        int wgid = (int)L; { const int q = nwg / NXCD, r = nwg % NXCD, xcd = wgid % NXCD, off = wgid / NXCD; wgid = (xcd < r ? xcd * (q + 1) : r * (q + 1) + (xcd - r) * q) + off; }
        const int nig = WGM * nN, gid = wgid / nig, fm = gid * WGM, gsz = (nM - fm) < WGM ? (nM - fm) : WGM;
        u.pm = fm + ((wgid % nig) % gsz); u.pn = (wgid % nig) / gsz; u.e = 0; u.nrows = BM; return true;
    }
    __device__ __forceinline__ unsigned a_off(const Unit& u, int r) const { return (unsigned)(u.pm * BM + r) * lda_bytes; }
    __device__ __forceinline__ size_t b_off(const Unit& u) const { return (size_t)u.pn * BM * (size_t)Kb; }
};
}

constexpr size_t MiB = 1u << 20;
constexpr size_t WS_CTL = 0, CTL_ZERO_BYTES = 1 * MiB;
constexpr size_t WS_ADA = 1 * MiB;
constexpr size_t WS_WIN = 2 * MiB;
constexpr size_t WS_WBR = 16 * MiB;
constexpr size_t WS_WOUT = 20 * MiB;
constexpr size_t WS_WRTR = 22 * MiB;
constexpr size_t WS_W2 = 23 * MiB;
constexpr size_t WS_HB = 56 * MiB;
constexpr size_t WS_XR = 88 * MiB;
constexpr size_t WS_YG = 120 * MiB;
constexpr size_t WS_Q = 152 * MiB;
constexpr size_t WS_K = 184 * MiB;
constexpr size_t WS_V = 216 * MiB;
constexpr size_t WS_G = 248 * MiB;
constexpr size_t WS_LOG = 56 * MiB;
constexpr size_t WS_LIST = 60 * MiB;
constexpr size_t WS_TOKW = 64 * MiB;
constexpr size_t WS_H = 68 * MiB;
constexpr size_t WS_Y = 149 * MiB;
constexpr size_t WS_U = 149 * MiB;
constexpr size_t WS_W1 = 181 * MiB;
constexpr size_t WS_END = 312 * MiB;
constexpr size_t W1_STRIDE = 512 * 1024 * 2, W2_STRIDE = 1024 * 256 * 2;
constexpr int CW_TMO = 0, CW_CODE = 1, CW_BAR = 4096, CW_CNT = 16384  ;

namespace pg8 {

struct EpiInProj {
    static constexpr bool HAS_MID = false;
    bf16_t *XR, *YG, *Q, *Kb, *V, *G;
    __device__ __forceinline__ void mid(f32x4 (&)[2][2][4][2], const Unit&, int, int, int, int) const {}
    __device__ __forceinline__ void operator()(const f32x4 (&acc)[2][2][4][2], const Unit& u, int wr, int wc, int fr, int fq) const {
        const int sec = u.pn >> 2;
        bf16_t* base; int ldc = 1024, colt = (u.pn & 3) * 256, act = 0;
        if (sec == 0) base = XR; else if (sec == 1) { base = YG; act = 1; } else if (sec == 2) { base = Q; act = 2; } else if (sec == 3) base = Kb; else if (sec == 4) base = V;
        else { base = G; ldc = 2048; colt = (u.pn - 20) * 256; act = 3; }
        const int row0 = u.pm * BM + wr * 64 + fr, col0 = colt + wc * 32 + 8 * fq;
#pragma unroll
        for (int ai = 0; ai < 2; ++ai)
#pragma unroll
            for (int m = 0; m < 4; ++m) { bf16_t* rowp = base + (size_t)(row0 + ai * HALF + m * 16) * ldc + col0;
#pragma unroll
                for (int bj = 0; bj < 2; ++bj) { f32x4 v0 = acc[ai][bj][m][0], v1 = acc[ai][bj][m][1];
                    if (act == 1) {
#pragma unroll
                        for (int j = 0; j < 4; ++j) { v0[j] = gelu_tanh(v0[j]); v1[j] = gelu_tanh(v1[j]); }
                    } else if (act == 2) { v0 = v0 * QSCALE; v1 = v1 * QSCALE; }
                    else if (act == 3) {
#pragma unroll
                        for (int j = 0; j < 4; ++j) { v0[j] = fast_sigmoid(v0[j]); v1[j] = fast_sigmoid(v1[j]); }
                    }
                    u32x4 w; w.x = pk2(v0[0], v0[1]); w.y = pk2(v0[2], v0[3]); w.z = pk2(v1[0], v1[1]); w.w = pk2(v1[2], v1[3]);
                    *(u32x4*)(rowp + bj * HALF) = w; } }
    }
};

struct EpiBranch {
    static constexpr bool HAS_MID = true;
    const bf16_t* G; bf16_t* O;
    __device__ __forceinline__ void mid(f32x4 (&acc)[2][2][4][2], const Unit& u, int wr, int wc, int fr, int fq) const {
        int row0 = u.pm * BM + wr * 64 + fr; const int col0 = u.pn * BM + wc * 32 + 8 * fq;
        asm volatile("" : "+v"(row0));
#pragma unroll
        for (int ai = 0; ai < 2; ++ai)
#pragma unroll
            for (int m = 0; m < 4; ++m) { const bf16_t* gp = G + (size_t)(row0 + ai * HALF + m * 16) * 2048 + col0;
#pragma unroll
                for (int bj = 0; bj < 2; ++bj) { const u32x4 gr = *(const u32x4*)(gp + bj * HALF), ga = *(const u32x4*)(gp + 1024 + bj * HALF);
#pragma unroll
                    for (int q = 0; q < 4; ++q) { const float r0 = bf_lo(gr[q]) * __builtin_amdgcn_rcpf(fmaxf(bf_lo(ga[q]), 1e-20f)), r1 = bf_hi(gr[q]) * __builtin_amdgcn_rcpf(fmaxf(bf_hi(ga[q]), 1e-20f));
                        acc[ai][bj][m][q >> 1][(q & 1) * 2] *= r0; acc[ai][bj][m][q >> 1][(q & 1) * 2 + 1] *= r1; } } }
    }
    __device__ __forceinline__ void operator()(const f32x4 (&acc)[2][2][4][2], const Unit& u, int wr, int wc, int fr, int fq) const {
        const int row0 = u.pm * BM + wr * 64 + fr, col0 = u.pn * BM + wc * 32 + 8 * fq;
#pragma unroll
        for (int ai = 0; ai < 2; ++ai)
#pragma unroll
            for (int m = 0; m < 4; ++m) { const size_t row = (size_t)(row0 + ai * HALF + m * 16);
#pragma unroll
                for (int bj = 0; bj < 2; ++bj) { const u32x4 ga = *(const u32x4*)(G + row * 2048 + 1024 + col0 + bj * HALF); float o[8];
#pragma unroll
                    for (int q = 0; q < 4; ++q) { o[2 * q] = acc[ai][bj][m][q >> 1][(q & 1) * 2] * fmaxf(bf_lo(ga[q]), 1e-20f); o[2 * q + 1] = acc[ai][bj][m][q >> 1][(q & 1) * 2 + 1] * fmaxf(bf_hi(ga[q]), 1e-20f); }
                    u32x4 w; w.x = pk2(o[0], o[1]); w.y = pk2(o[2], o[3]); w.z = pk2(o[4], o[5]); w.w = pk2(o[6], o[7]);
                    *(u32x4*)(O + row * 1024 + col0 + bj * HALF) = w; } }
    }
};

struct EpiOutProj {
    static constexpr bool HAS_MID = false;
    const float* x; const float* ada; float* out;
    __device__ __forceinline__ void mid(f32x4 (&)[2][2][4][2], const Unit&, int, int, int, int) const {}
    __device__ __forceinline__ void operator()(const f32x4 (&acc)[2][2][4][2], const Unit& u, int wr, int wc, int fr, int fq) const {
        const int row0 = u.pm * BM + wr * 64 + fr, col0 = u.pn * BM + wc * 32 + 8 * fq;
        const float* g1 = ada + (size_t)((u.pm * BM) / SEQ) * 6144 + 2048;
#pragma unroll
        for (int bj = 0; bj < 2; ++bj) { const f32x4 ga = *(const f32x4*)(g1 + col0 + bj * HALF), gb = *(const f32x4*)(g1 + col0 + bj * HALF + 4);
#pragma unroll
            for (int ai = 0; ai < 2; ++ai)
#pragma unroll
                for (int m = 0; m < 4; ++m) { const size_t off = (size_t)(row0 + ai * HALF + m * 16) * 1024 + col0 + bj * HALF;
                    const f32x4 xa = *(const f32x4*)(x + off), xb = *(const f32x4*)(x + off + 4);
                    *(f32x4*)(out + off) = xa * ALPHA_DN + ga * acc[ai][bj][m][0]; *(f32x4*)(out + off + 4) = xb * ALPHA_DN + gb * acc[ai][bj][m][1]; } }
    }
};

struct EpiRouter {
    static constexpr bool HAS_MID = false;
    float* logits;
    __device__ __forceinline__ void mid(f32x4 (&)[2][2][4][2], const Unit&, int, int, int, int) const {}
    __device__ __forceinline__ void operator()(const f32x4 (&acc)[2][2][4][2], const Unit& u, int wr, int wc, int fr, int fq) const {
        if (wc >= 2) return;
        const int row0 = u.pm * BM + wr * 64 + fr, col0 = wc * 32 + 8 * fq;
#pragma unroll
        for (int ai = 0; ai < 2; ++ai)
#pragma unroll
            for (int m = 0; m < 4; ++m) { float* p = logits + (size_t)(row0 + ai * HALF + m * 16) * 64 + col0; *(f32x4*)p = acc[ai][0][m][0]; *(f32x4*)(p + 4) = acc[ai][0][m][1]; }
    }
};

struct ExpertTables { const LAS int* tp; const LAS int* cnt; const LAS unsigned char* rt2e; int RT; };
struct ExpertSched {
    ExpertTables T; int nN, G, c; const unsigned* list; int mode;
    size_t bstride, bsub;
    int pn0;
    __device__ __forceinline__ bool next(int i, Unit& u) const {
        const long L = (long)i * G + c; if (L >= (long)T.RT * nN) return false;
        const int rt = (int)(L / nN); u.pn = (int)(L % nN); const int e = T.rt2e[rt]; u.e = e; u.pm = rt - T.tp[e];
        const int left = T.cnt[e] - u.pm * BM; u.nrows = left < BM ? left : BM; return true;
    }
    __device__ __forceinline__ unsigned a_off(const Unit& u, int r) const {
        if (mode == 1) return (unsigned)((T.tp[u.e] + u.pm) * BM + r) * 512u;
        const int rr = r < u.nrows ? r : u.nrows - 1; const int slot = u.pm * BM + rr;
        const unsigned tok = (u.e == NEXP) ? (unsigned)slot : (list[(size_t)u.e * M + slot] >> 4);
        return tok * 2048u;
    }
    __device__ __forceinline__ size_t b_off(const Unit& u) const { return (size_t)u.e * bstride + (size_t)(pn0 + u.pn) * bsub; }
};

struct EpiGemm1 {
    static constexpr bool HAS_MID = false;
    ExpertTables T; const unsigned* list; const float* tokw; bf16_t* H;
    __device__ __forceinline__ void mid(f32x4 (&)[2][2][4][2], const Unit&, int, int, int, int) const {}
    __device__ __forceinline__ void operator()(const f32x4 (&acc)[2][2][4][2], const Unit& u, int wr, int wc, int fr, int fq) const {
        const int hrow0 = (T.tp[u.e] + u.pm) * BM, col0 = u.pn * HALF + wc * 32 + 8 * fq;
#pragma unroll
        for (int ai = 0; ai < 2; ++ai)
#pragma unroll
            for (int m = 0; m < 4; ++m) { const int r = ai * HALF + wr * 64 + m * 16 + fr;
                if (r < u.nrows) { float w = 1.f;
                    if (u.e != NEXP) { const unsigned ent = list[(size_t)u.e * M + u.pm * BM + r]; w = tokw[(size_t)(ent >> 4) * 8 + (ent & 15u)]; }
                    float o[8];
#pragma unroll
                    for (int n = 0; n < 2; ++n)
#pragma unroll
                        for (int j = 0; j < 4; ++j) { const float gt = acc[ai][0][m][n][j], up = acc[ai][1][m][n][j]; o[4 * n + j] = gt * fast_sigmoid(gt) * up * w; }
                    u32x4 pw; pw.x = pk2(o[0], o[1]); pw.y = pk2(o[2], o[3]); pw.z = pk2(o[4], o[5]); pw.w = pk2(o[6], o[7]);
                    *(u32x4*)(H + (size_t)(hrow0 + r) * 256 + col0) = pw; } }
    }
};

struct EpiGemm2 {
    static constexpr bool HAS_MID = false;
    const unsigned* list; bf16_t* Y;
    __device__ __forceinline__ void mid(f32x4 (&)[2][2][4][2], const Unit&, int, int, int, int) const {}
    __device__ __forceinline__ void operator()(const f32x4 (&acc)[2][2][4][2], const Unit& u, int wr, int wc, int fr, int fq) const {
        const int col0 = u.pn * BM + wc * 32 + 8 * fq;
#pragma unroll
        for (int ai = 0; ai < 2; ++ai)
#pragma unroll
            for (int m = 0; m < 4; ++m) { const int r = ai * HALF + wr * 64 + m * 16 + fr;
                if (r < u.nrows) { unsigned dst;
                    if (u.e != NEXP) { const unsigned ent = list[(size_t)u.e * M + u.pm * BM + r]; dst = (ent >> 4) * NSLOTK + (ent & 15u); } else dst = (unsigned)(u.pm * BM + r) * NSLOTK + 8u;
                    bf16_t* yp = Y + (size_t)dst * 512 + col0;
#pragma unroll
                    for (int bj = 0; bj < 2; ++bj) { const f32x4 v0 = acc[ai][bj][m][0], v1 = acc[ai][bj][m][1];
                        u32x4 w; w.x = pk2(v0[0], v0[1]); w.y = pk2(v0[2], v0[3]); w.z = pk2(v1[0], v1[1]); w.w = pk2(v1[2], v1[3]);
                        *(u32x4*)(yp + bj * HALF) = w; } } }
    }
};
}

namespace att {
constexpr int SLOT = 32768, KOFF = 0, VOFF = 16384, WSF_OFF = 3 * SLOT  , STG_ROW = 132  , STG_BYTES = 32 * STG_ROW * 4;
__device__ __forceinline__ int crow(int r, int hi) { return (r & 3) + 8 * (r >> 2) + 4 * hi; }
__device__ __forceinline__ s16x4 vtr(const LAS unsigned char* p) { typedef short v4i16_t __attribute__((ext_vector_type(4))); return __builtin_bit_cast(s16x4, __builtin_amdgcn_ds_read_tr16_b64_v4i16((LAS v4i16_t*)p)); }

__device__ __forceinline__ void attn_unit(int b, int h, int qb, const bf16_t* Qg, const bf16_t* Kg, const bf16_t* Vg, bf16_t* Og, LAS unsigned char* lds, float lam, const float* subln_g) {
    const int tid = threadIdx.x, lane = tid & 63, r32 = lane & 31, hi = lane >> 5; const int wid = __builtin_amdgcn_readfirstlane(tid >> 6);
    const int c = wid >> 2, wq = wid & 3;
    const size_t rowbase = (size_t)b * SEQ; const int q0 = qb * 128;
    const int NT = 2 * qb + 2, ntw = 2 * qb + 1 + (wq >> 1);
    const bf16_t* Kh = Kg + rowbase * 1024 + h * 128; const bf16_t* Vh = Vg + rowbase * 1024 + h * 128;
    const bf16_t* ksrc0 = Kh + (size_t)lane * 1024 + wid * 8; const bf16_t* ksrc1 = ksrc0 + 64;
    const bf16_t* vsrc0 = Vh + (size_t)((wid & 3) * 16 + (lane >> 2)) * 1024 + (wid >> 2) * 32 + (lane & 3) * 8; const bf16_t* vsrc1 = vsrc0 + 64;
    const unsigned kd0 = wid * 1024, kd1 = (wid + 8) * 1024;
#define ATT_DMA(t, slot) do { const size_t _o = (size_t)(t) * 64 * 1024; \
        __builtin_amdgcn_global_load_lds((const unsigned*)(ksrc0 + _o), (LAS unsigned*)(lds + (slot) * SLOT + KOFF + kd0), 16, 0, 0); \
        __builtin_amdgcn_global_load_lds((const unsigned*)(ksrc1 + _o), (LAS unsigned*)(lds + (slot) * SLOT + KOFF + kd1), 16, 0, 0); \
        __builtin_amdgcn_global_load_lds((const unsigned*)(vsrc0 + _o), (LAS unsigned*)(lds + (slot) * SLOT + VOFF + kd0), 16, 0, 0); \
        __builtin_amdgcn_global_load_lds((const unsigned*)(vsrc1 + _o), (LAS unsigned*)(lds + (slot) * SLOT + VOFF + kd1), 16, 0, 0); } while (0)
    ATT_DMA(0, 0);
    const bf16_t* Qw = Qg + (rowbase + q0 + wq * 32 + r32) * 1024 + h * 128 + c * 64 + hi * 8;
    bf16x8 qr[4];
#pragma unroll
    for (int d0 = 0; d0 < 4; ++d0) qr[d0] = *(const bf16x8*)(Qw + d0 * 16);
    f32x16 o[4];
#pragma unroll
    for (int d = 0; d < 4; ++d)
#pragma unroll
        for (int r = 0; r < 16; ++r) o[d][r] = 0.f;
    float m_run = -1e30f, l_run = 0.f;
    LAS float* wsf = (LAS float*)(lds + WSF_OFF) + wid * 64;
    const int kro = (c * 8 + hi) * 1024 + r32 * 16;
    const int vro = (4 * hi + ((lane & 15) >> 2)) * 64 + ((lane >> 4) & 1) * 32 + (lane & 3) * 8;
    int slot = 0, nslot = 1;
    for (int t = 0; t < NT; ++t) {
        if (t + 1 < NT) { ATT_DMA(t + 1, nslot); asm volatile("s_waitcnt vmcnt(4)" ::: "memory"); }
        else asm volatile("s_waitcnt vmcnt(0)" ::: "memory");
        __builtin_amdgcn_s_barrier(); asm volatile("" ::: "memory");
        if (t < ntw) {
            const LAS unsigned char* Ks = lds + slot * SLOT + KOFF + kro; const LAS unsigned char* Vs = lds + slot * SLOT + VOFF + vro;
            f32x16 p0, p1;
#pragma unroll
            for (int r = 0; r < 16; ++r) { p0[r] = 0.f; p1[r] = 0.f; }
#pragma unroll
            for (int d0 = 0; d0 < 4; ++d0) { const bf16x8 k0 = *(const LAS bf16x8*)(Ks + d0 * 2048), k1 = *(const LAS bf16x8*)(Ks + d0 * 2048 + 512);
                p0 = __builtin_amdgcn_mfma_f32_32x32x16_bf16(k0, qr[d0], p0, 0, 0, 0); p1 = __builtin_amdgcn_mfma_f32_32x32x16_bf16(k1, qr[d0], p1, 0, 0, 0); }
            float mx = fmaxf(p0[0], p1[0]);
#pragma unroll
            for (int r = 1; r < 16; ++r) mx = fmaxf(mx, fmaxf(p0[r], p1[r]));
            mx = fmaxf(mx, __shfl_xor(mx, 32));
            const float m_new = fmaxf(m_run, mx), alpha = __builtin_amdgcn_exp2f(m_run - m_new); m_run = m_new;
            float ls = 0.f;
#pragma unroll
            for (int r = 0; r < 16; ++r) { p0[r] = __builtin_amdgcn_exp2f(p0[r] - m_new); p1[r] = __builtin_amdgcn_exp2f(p1[r] - m_new); ls += p0[r] + p1[r]; }
            l_run = l_run * alpha + ls;
            if (hi == 0) wsf[r32] = alpha;
#pragma unroll
            for (int g = 0; g < 4; ++g) { const f32x4 a4 = *(const LAS f32x4*)(wsf + 8 * g + 4 * hi);
#pragma unroll
                for (int d = 0; d < 4; ++d)
#pragma unroll
                    for (int k = 0; k < 4; ++k) o[d][4 * g + k] *= a4[k]; }
            bf16x8 pw[4];
#pragma unroll
            for (int s = 0; s < 2; ++s) { u32x4 w0, w1;
#pragma unroll
                for (int q = 0; q < 4; ++q) { w0[q] = pk2(p0[8 * s + 2 * q], p0[8 * s + 2 * q + 1]); w1[q] = pk2(p1[8 * s + 2 * q], p1[8 * s + 2 * q + 1]); }
                pw[s] = __builtin_bit_cast(bf16x8, w0); pw[2 + s] = __builtin_bit_cast(bf16x8, w1); }
#pragma unroll
            for (int d = 0; d < 4; ++d)
#pragma unroll
                for (int ks = 0; ks < 4; ++ks) { const s16x4 lo = vtr(Vs + d * 4096 + ks * 1024), hh = vtr(Vs + d * 4096 + ks * 1024 + 512);
                    const bf16x8 vf = (bf16x8){lo[0], lo[1], lo[2], lo[3], hh[0], hh[1], hh[2], hh[3]};
                    o[d] = __builtin_amdgcn_mfma_f32_32x32x16_bf16(pw[ks], vf, o[d], 0, 0, 0); }
        }
        slot = nslot; nslot = (nslot == 2) ? 0 : nslot + 1;
    }
    { const float lt = l_run + __shfl_xor(l_run, 32); const float inv = 1.0f / lt;
      if (hi == 0) wsf[r32] = inv;
#pragma unroll
      for (int g = 0; g < 4; ++g) { const f32x4 a4 = *(const LAS f32x4*)(wsf + 8 * g + 4 * hi);
#pragma unroll
          for (int d = 0; d < 4; ++d)
#pragma unroll
              for (int k = 0; k < 4; ++k) o[d][4 * g + k] *= a4[k]; } }
    asm volatile("s_waitcnt lgkmcnt(0)" ::: "memory"); __builtin_amdgcn_s_barrier(); asm volatile("" ::: "memory");
    LAS float* stg = (LAS float*)(lds + wq * STG_BYTES);
    if (c == 1) {
#pragma unroll
        for (int d = 0; d < 4; ++d)
#pragma unroll
            for (int r = 0; r < 16; ++r) stg[crow(r, hi) * STG_ROW + d * 32 + r32] = o[d][r];
    }
    asm volatile("s_waitcnt lgkmcnt(0)" ::: "memory"); __builtin_amdgcn_s_barrier(); asm volatile("" ::: "memory");
    if (c == 0) {
#pragma unroll
        for (int d = 0; d < 4; ++d)
#pragma unroll
            for (int r = 0; r < 16; ++r) { LAS float* p = stg + crow(r, hi) * STG_ROW + d * 32 + r32; *p = o[d][r] - lam * (*p); }
        asm volatile("s_waitcnt lgkmcnt(0)" ::: "memory");
        const int row = lane >> 1, hf = lane & 1; const LAS float* rp = stg + row * STG_ROW + hf * 64;
        f32x4 v[16]; float ss = 0.f;
#pragma unroll
        for (int i = 0; i < 16; ++i) { v[i] = *(const LAS f32x4*)(rp + 4 * i); ss += v[i][0] * v[i][0] + v[i][1] * v[i][1] + v[i][2] * v[i][2] + v[i][3] * v[i][3]; }
        ss += __shfl_xor(ss, 1);
        const float rs = (1.0f - LAM_INIT) / sqrtf(ss * (1.0f / 128.0f) + RMS_EPS);
        bf16_t* op = Og + (rowbase + q0 + wq * 32 + row) * 1024 + h * 128 + hf * 64; const float* gp = subln_g + hf * 64;
#pragma unroll
        for (int i = 0; i < 8; ++i) { const f32x4 ga = *(const f32x4*)(gp + 8 * i), gb = *(const f32x4*)(gp + 8 * i + 4); const f32x4 a = v[2 * i] * ga * rs, bq = v[2 * i + 1] * gb * rs;
            u32x4 w; w.x = pk2(a[0], a[1]); w.y = pk2(a[2], a[3]); w.z = pk2(bq[0], bq[1]); w.w = pk2(bq[2], bq[3]); *(u32x4*)(op + 8 * i) = w; }
    }
    asm volatile("s_waitcnt lgkmcnt(0)" ::: "memory"); __builtin_amdgcn_s_barrier(); asm volatile("" ::: "memory");
#undef ATT_DMA
}
}

namespace rg {
constexpr int CW_OFF = 0  , AGG_OFF = 2048  ;
__device__ __forceinline__ int crow(int r, int hi) { return (r & 3) + 8 * (r >> 2) + 4 * hi; }

__device__ __forceinline__ void rglru_unit(int b, int n, int hf, const bf16_t* XR, bf16_t* YG, const float* conv_w, const float* conv_b,
                                           const float* w_a, const float* b_a, const float* w_i, const float* b_i, const float* lam, LAS unsigned char* lds) {
    const int tid = threadIdx.x, lane = tid & 63, r32 = lane & 31, hi = lane >> 5; const int wid = __builtin_amdgcn_readfirstlane(tid >> 6);
    const int c0 = n * 64 + hf * 32, ch = c0 + r32;
    LAS float* cw = (LAS float*)(lds + CW_OFF);
    if (tid < 256) cw[tid] = conv_w[(tid >> 6) * 1024 + n * 64 + (tid & 63)]; else if (tid < 320) cw[tid] = conv_b[n * 64 + (tid - 256)];
    bf16x8 wa[4], wi[4], idm[2];
#pragma unroll
    for (int s = 0; s < 4; ++s) { u32x4 ua, ui;
#pragma unroll
        for (int q = 0; q < 4; ++q) { const size_t o0 = ((size_t)n * 64 + 16 * s + 8 * hi + 2 * q) * 64 + hf * 32 + r32;
            ua[q] = pk2(w_a[o0], w_a[o0 + 64]); ui[q] = pk2(w_i[o0], w_i[o0 + 64]); }
        wa[s] = __builtin_bit_cast(bf16x8, ua); wi[s] = __builtin_bit_cast(bf16x8, ui); }
#pragma unroll
    for (int s = 0; s < 2; ++s) { u32x4 ud;
#pragma unroll
        for (int q = 0; q < 4; ++q) { const int k0 = 16 * s + 8 * hi + 2 * q; ud[q] = (k0 == r32 ? 0x3f80u : 0u) | (k0 + 1 == r32 ? 0x3f800000u : 0u); }
        idm[s] = __builtin_bit_cast(bf16x8, ud); }
    const float ba = b_a[ch], bi = b_i[ch];
    const float lmb = lam[ch]; const float sp = (lmb < -20.f) ? -lmb : log1pf(expf(-lmb));
    const float nsp8 = -8.0f * sp * LOG2E;
    float carry = 0.f;
    const size_t rowbase = (size_t)b * SEQ;
    __syncthreads();
    for (int bt = 0; bt < SEQ / 256; ++bt) {
        const int t0 = bt * 256 + wid * 32;
        bf16x8 xa[4];
        int xo = (int)((rowbase + t0 + r32) * 1024 + n * 64 + 8 * hi); asm volatile("" : "+v"(xo));
#pragma unroll
        for (int s = 0; s < 4; ++s) { const int cl = 16 * s + 8 * hi; float v[8];
            { const f32x4 b0 = *(const LAS f32x4*)(cw + 256 + cl), b1 = *(const LAS f32x4*)(cw + 256 + cl + 4);
#pragma unroll
              for (int j = 0; j < 4; ++j) { v[j] = b0[j]; v[4 + j] = b1[j]; } }
#pragma unroll
            for (int tap = 0; tap < 4; ++tap) { const int tt = t0 + r32 - 3 + tap;
                u32x4 xv = *(const u32x4*)(XR + xo + (tap - 3) * 1024 + 16 * s);
                if (tt < 0) xv = (u32x4){0u, 0u, 0u, 0u};
                const f32x4 w0 = *(const LAS f32x4*)(cw + tap * 64 + cl), w1 = *(const LAS f32x4*)(cw + tap * 64 + cl + 4);
                v[0] += w0[0] * bf_lo(xv[0]); v[1] += w0[1] * bf_hi(xv[0]); v[2] += w0[2] * bf_lo(xv[1]); v[3] += w0[3] * bf_hi(xv[1]);
                v[4] += w1[0] * bf_lo(xv[2]); v[5] += w1[1] * bf_hi(xv[2]); v[6] += w1[2] * bf_lo(xv[3]); v[7] += w1[3] * bf_hi(xv[3]); }
            u32x4 pw; pw.x = pk2(v[0], v[1]); pw.y = pk2(v[2], v[3]); pw.z = pk2(v[4], v[5]); pw.w = pk2(v[6], v[7]); xa[s] = __builtin_bit_cast(bf16x8, pw); __builtin_amdgcn_sched_barrier(0); }
        bf16x8 ya[2];
        int yo = (int)((rowbase + t0 + r32) * 1024 + c0 + 8 * hi); asm volatile("" : "+v"(yo));
#pragma unroll
        for (int s = 0; s < 2; ++s) ya[s] = *(const bf16x8*)(YG + yo + 16 * s);
        f32x16 ga, gi, xc, yg;
#pragma unroll
        for (int r = 0; r < 16; ++r) { ga[r] = 0.f; gi[r] = 0.f; xc[r] = 0.f; yg[r] = 0.f; }
#pragma unroll
        for (int s = 0; s < 4; ++s) { ga = __builtin_amdgcn_mfma_f32_32x32x16_bf16(xa[s], wa[s], ga, 0, 0, 0); gi = __builtin_amdgcn_mfma_f32_32x32x16_bf16(xa[s], wi[s], gi, 0, 0, 0); }
        if (hf == 0) { xc = __builtin_amdgcn_mfma_f32_32x32x16_bf16(xa[0], idm[0], xc, 0, 0, 0); xc = __builtin_amdgcn_mfma_f32_32x32x16_bf16(xa[1], idm[1], xc, 0, 0, 0); }
        else         { xc = __builtin_amdgcn_mfma_f32_32x32x16_bf16(xa[2], idm[0], xc, 0, 0, 0); xc = __builtin_amdgcn_mfma_f32_32x32x16_bf16(xa[3], idm[1], xc, 0, 0, 0); }
        yg = __builtin_amdgcn_mfma_f32_32x32x16_bf16(ya[0], idm[0], yg, 0, 0, 0); yg = __builtin_amdgcn_mfma_f32_32x32x16_bf16(ya[1], idm[1], yg, 0, 0, 0);
        float a[16], u[16];
#pragma unroll
        for (int r = 0; r < 16; ++r) { const float rr = fast_sigmoid(ga[r] + ba), ii = fast_sigmoid(gi[r] + bi);
            const float av = __builtin_amdgcn_exp2f(nsp8 * rr); a[r] = av; u[r] = xc[r] * ii * __builtin_amdgcn_sqrtf(fmaxf(1.0f - av * av, 0.f)); if ((r & 3) == 3) __builtin_amdgcn_sched_barrier(0); }
        float mA[4], mB[4], oA[4], oB[4];
#pragma unroll
        for (int g = 0; g < 4; ++g) { float A = a[4 * g], Bv = u[4 * g];
#pragma unroll
            for (int k = 1; k < 4; ++k) { A *= a[4 * g + k]; Bv = Bv * a[4 * g + k] + u[4 * g + k]; }
            mA[g] = A; mB[g] = Bv; oA[g] = __shfl_xor(A, 32); oB[g] = __shfl_xor(Bv, 32); }
        __builtin_amdgcn_sched_barrier(0);
        float TA = 1.f, TB = 0.f;
#pragma unroll
        for (int g = 0; g < 4; ++g) { const float fA = hi ? oA[g] : mA[g], fB = hi ? oB[g] : mB[g], sA = hi ? mA[g] : oA[g], sB = hi ? mB[g] : oB[g];
            TB = TB * fA + fB; TA *= fA; TB = TB * sA + sB; TA *= sA; }
        LAS f32x2* agg = (LAS f32x2*)(lds + AGG_OFF) + (bt & 1) * 256;
        if (hi == 0) agg[wid * 32 + r32] = (f32x2){TA, TB};
        asm volatile("s_waitcnt lgkmcnt(0)" ::: "memory"); __builtin_amdgcn_s_barrier(); asm volatile("" ::: "memory");
        float hin = carry, hall = carry;
#pragma unroll
        for (int w = 0; w < 8; ++w) { const f32x2 ab = agg[w * 32 + r32]; hall = hall * ab[0] + ab[1]; if (w < wid) hin = hall; }
        carry = hall;
        float s = hin;
        int so = (int)((rowbase + t0 + 4 * hi) * 1024 + ch); asm volatile("" : "+v"(so));
#pragma unroll
        for (int g = 0; g < 4; ++g) { float st;
            if (hi) { s = s * oA[g] + oB[g]; st = s; s = s * mA[g] + mB[g]; } else { st = s; s = s * mA[g] + mB[g]; s = s * oA[g] + oB[g]; }
#pragma unroll
            for (int k = 0; k < 4; ++k) { st = st * a[4 * g + k] + u[4 * g + k];
                YG[so + (8 * g + k) * 1024] = (bf16_t)f2bf(st * yg[4 * g + k]); }
            __builtin_amdgcn_sched_barrier(0); }
    }
    __syncthreads();
}
}

constexpr int NWAVES = 8;
#ifndef MK_N_LAUNCHES
#define MK_N_LAUNCHES 1
#endif
constexpr int N_PHASES = 14;
constexpr int RING_OFF = 0, RING_BYTES = 131072;
constexpr int TAB_OFF = RING_BYTES;
constexpr int TAB_TP = TAB_OFF, TAB_CNT = TAB_OFF + 272, TAB_RT2E = TAB_OFF + 544, TAB_END = TAB_RT2E + 704;
constexpr int LDSCTL_OFF = RING_BYTES + 2048, MISC_OFF = LDSCTL_OFF + 320;
constexpr int LDS_BYTES = 147456;
static_assert(TAB_END <= LDSCTL_OFF && MISC_OFF + 128 <= LDS_BYTES, "LDS map");

typedef GAS unsigned gu32;
#define RLX_AGENT __ATOMIC_RELAXED, __HIP_MEMORY_SCOPE_AGENT
#define LDS_WAIT() asm volatile("s_waitcnt lgkmcnt(0)" ::: "memory")
#define VM_WAIT() asm volatile("s_waitcnt vmcnt(0)" ::: "memory")

#define XB_TMO      128
#define XB_XCNT(j)  (256  + 64 * (j))
#define XB_XSUB(j)  (1280 + 64 * (j))
#define XB_XGEN(j)  (2304 + 64 * (j))
#define XB_TOP      3328
#define XB_TOPGEN   3392
#define XCD_BAR_WORDS 3456
#define XB_SPIN_CAP (1u << 18)
__device__ __forceinline__ unsigned xb_ld(unsigned* p)              { return __hip_atomic_load(p, __ATOMIC_RELAXED, __HIP_MEMORY_SCOPE_AGENT); }
__device__ __forceinline__ unsigned xb_add(unsigned* p, unsigned v) { return __hip_atomic_fetch_add(p, v, __ATOMIC_RELAXED, __HIP_MEMORY_SCOPE_AGENT); }
__device__ __forceinline__ unsigned xb_xcc_id() { return (unsigned)__builtin_amdgcn_s_getreg((3 << 11) | 20) & 0xFu; }
#define XB_SPIN(cond, bar) do { unsigned _sp = 0; while (cond) { __builtin_amdgcn_s_sleep(1); \
    if ((++_sp & 255u) == 0u) { if (xb_ld(&(bar)[XB_TMO])) break; if (_sp > XB_SPIN_CAP) { atomicAdd(&(bar)[XB_TMO], 1u); break; } } } } while (0)
struct XcdBarrier { unsigned* bar; unsigned x; volatile LAS unsigned* st; };
__device__ __forceinline__ XcdBarrier xcd_barrier_post(unsigned* bar, volatile LAS unsigned* st) {
    XcdBarrier b; b.bar = bar; b.x = xb_xcc_id(); b.st = st;
    if (threadIdx.x == 0) (void)xb_add(&bar[XB_XCNT(b.x)], 1u);
    return b;
}
__device__ __forceinline__ void xcd_barrier_complete(unsigned* bar, unsigned x, unsigned& nloc, unsigned& nx) {
    const unsigned G = gridDim.x * gridDim.y * gridDim.z;
    unsigned sum, cnt, mine, sp = 0u;
    for (;;) {
        sum = 0u; cnt = 0u; mine = 0u;
#pragma unroll
        for (unsigned j = 0; j < 16; ++j) { const unsigned c = xb_ld(&bar[XB_XCNT(j)]); sum += c; cnt += (c > 0u) ? 1u : 0u; mine = (j == x) ? c : mine; }
        if (sum == G) break;
        __builtin_amdgcn_s_sleep(1);
        if ((++sp & 255u) == 0u) { if (xb_ld(&bar[XB_TMO])) break; if (sp > XB_SPIN_CAP) { atomicAdd(&bar[XB_TMO], 1u); break; } }
    }
    nloc = mine > 0u ? mine : 1u; nx = cnt > 0u ? cnt : 1u;
}
__device__ __forceinline__ void xcd_barrier(const XcdBarrier& b) {
    asm volatile("s_waitcnt vmcnt(0)" ::: "memory");
    __syncthreads();
    if (threadIdx.x == 0) {
        unsigned* bar = b.bar;
        __builtin_amdgcn_s_waitcnt(0);
        unsigned nloc = b.st[0], nx = b.st[1];
        if (nloc == 0u) { xcd_barrier_complete(bar, b.x, nloc, nx); b.st[0] = nloc; b.st[1] = nx; }
        const unsigned old = xb_add(&bar[XB_XSUB(b.x)], 1u);
        const unsigned gen = old / nloc;
        if (old + 1u == (gen + 1u) * nloc) {
            __builtin_amdgcn_fence(__ATOMIC_RELEASE, "agent");
            asm volatile("s_waitcnt vmcnt(0)" ::: "memory");
            const unsigned og = xb_add(&bar[XB_TOP], 1u);
            const unsigned tg = og / nx;
            if (og + 1u == (tg + 1u) * nx) xb_add(&bar[XB_TOPGEN], 1u);
            else XB_SPIN(xb_ld(&bar[XB_TOPGEN]) == tg, bar);
            __builtin_amdgcn_fence(__ATOMIC_ACQUIRE, "agent");
            xb_add(&bar[XB_XGEN(b.x)], 1u);
            asm volatile("s_waitcnt vmcnt(0)" ::: "memory");
        } else {
            XB_SPIN(xb_ld(&bar[XB_XGEN(b.x)]) == gen, bar);
            __builtin_amdgcn_fence(__ATOMIC_ACQUIRE, "agent");
            asm volatile("s_waitcnt vmcnt(0)" ::: "memory");
        }
    }
    __syncthreads();
}

struct Inputs {
    const float *x, *c, *w_ada, *b_ada, *w_in, *conv_w, *conv_b, *lru_w_a, *lru_b_a, *lru_w_i, *lru_b_i, *lru_lambda,
                *lam_q1, *lam_k1, *lam_q2, *lam_k2, *subln_g, *p_rnn, *p_attn, *w_out, *ln1_g, *ln1_b,
                *w_router, *router_bias, *we_gate, *we_up, *we_down, *ws_gate, *ws_up, *ws_down, *ln2_g, *ln2_b;
};
struct Args { Inputs in; float* out; unsigned char* ws; int ph_lo, ph_hi, li, pad; };

__device__ __forceinline__ float wave_sum(float v) {
#pragma unroll
    for (int o = 1; o < 64; o <<= 1) v += __shfl_xor(v, o);
    return v;
}

__device__ __forceinline__ void transpose_item(const float* W, int ldw, int k0, int n0, bf16_t* WT, size_t ldo, int orow0, int ocol0, LAS float* scr, int lane) {
#pragma unroll 8
    for (int i = 0; i < 32; ++i) { const int kk = 2 * i + (lane >> 5); scr[kk * 33 + (lane & 31)] = W[(size_t)(k0 + kk) * ldw + n0 + (lane & 31)]; }
    LDS_WAIT(); asm volatile("" ::: "memory");
    const int c = lane & 7;
#pragma unroll
    for (int j = 0; j < 4; ++j) { const int n = (lane >> 3) + 8 * j; const LAS float* s = scr + (8 * c) * 33 + n;
        u32x4 o; o.x = pk2(s[0 * 33], s[1 * 33]); o.y = pk2(s[2 * 33], s[3 * 33]); o.z = pk2(s[4 * 33], s[5 * 33]); o.w = pk2(s[6 * 33], s[7 * 33]);
        *(GAS u32x4*)(WT + (size_t)(orow0 + n) * ldo + ocol0 + k0 + 8 * c) = o; }
    LDS_WAIT(); asm volatile("" ::: "memory");
}

__global__ void __launch_bounds__(NWAVES * 64, 2) mk_fwd(Args args) {
    extern __shared__ __attribute__((aligned(16))) unsigned char lds_raw[];
    LAS unsigned char* lds = (LAS unsigned char*)lds_raw;
    volatile LAS unsigned* MISC = (volatile LAS unsigned*)(lds + MISC_OFF);
    const int tid = threadIdx.x, lane = tid & 63, wave = __builtin_amdgcn_readfirstlane(tid >> 6);
    const int G = gridDim.x; const int bx = blockIdx.x; const int vcu = (G % 8 == 0) ? (bx % 8) * (G / 8) + bx / 8 : bx;
    const int gw = vcu * NWAVES + wave, NGW = G * NWAVES;
    unsigned char* ws = args.ws; const Inputs& I = args.in;
    gu32* ctl = (gu32*)(ws + WS_CTL);
    float* ADA = (float*)(ws + WS_ADA);
    bf16_t* WIN = (bf16_t*)(ws + WS_WIN); bf16_t* WBR = (bf16_t*)(ws + WS_WBR); bf16_t* WOUT = (bf16_t*)(ws + WS_WOUT); bf16_t* WRTR = (bf16_t*)(ws + WS_WRTR);
    bf16_t* W1 = (bf16_t*)(ws + WS_W1); bf16_t* W2 = (bf16_t*)(ws + WS_W2);
    bf16_t* HB = (bf16_t*)(ws + WS_HB); bf16_t* XR = (bf16_t*)(ws + WS_XR); bf16_t* YG = (bf16_t*)(ws + WS_YG); bf16_t* QB = (bf16_t*)(ws + WS_Q);
    bf16_t* KB = (bf16_t*)(ws + WS_K); bf16_t* VB = (bf16_t*)(ws + WS_V); bf16_t* GB = (bf16_t*)(ws + WS_G); bf16_t* MRG = (bf16_t*)(ws + WS_XR);
    bf16_t* UB = (bf16_t*)(ws + WS_U); float* LOGITS = (float*)(ws + WS_LOG); unsigned* LIST = (unsigned*)(ws + WS_LIST); float* TOKW = (float*)(ws + WS_TOKW);
    bf16_t* HX = (bf16_t*)(ws + WS_H); bf16_t* YS = (bf16_t*)(ws + WS_Y);
    float* OUT = args.out;

    for (int u = tid; u < (LDS_BYTES - LDSCTL_OFF) / 4; u += NWAVES * 64) ((LAS unsigned*)(lds + LDSCTL_OFF))[u] = 0u;
    __syncthreads();
    XcdBarrier bar; bar.bar = (unsigned*)(ctl + CW_BAR); bar.x = 0; bar.st = nullptr;
    if (MK_N_LAUNCHES == 1) bar = xcd_barrier_post((unsigned*)(ctl + CW_BAR), MISC + 8);
    const int lo = args.ph_lo, hi = args.ph_hi;
#ifndef PH_MASK
#define PH_MASK 0xFFFF
#endif
#define IN(k) ((((PH_MASK) >> (k)) & 1) && lo <= (k) && (k) < hi)
#define SEAM(k) do { if (IN(k) && IN((k) + 1)) xcd_barrier(bar); } while (0)

    if (IN(0)) {
        if (vcu < 96) {
            LAS float* sc = (LAS float*)(lds + RING_OFF);
            LAS float* red = (LAS float*)(lds + RING_OFF + 32768);
            for (int i = tid; i < 8192; i += NWAVES * 64) { const int b = i >> 10, k = i & 1023; const float cv = I.c[i]; sc[k * 8 + b] = cv * fast_sigmoid(cv); }
            __syncthreads();
            float a8[8];
#pragma unroll
            for (int b = 0; b < 8; ++b) a8[b] = 0.f;
            const float* wp = I.w_ada + (size_t)(wave * 128) * 6144 + vcu * 64 + lane;
#pragma unroll 8
            for (int k = 0; k < 128; ++k) { const float w = wp[(size_t)k * 6144]; const f32x4 s0 = *(const LAS f32x4*)(sc + (wave * 128 + k) * 8), s1 = *(const LAS f32x4*)(sc + (wave * 128 + k) * 8 + 4);
                a8[0] += s0[0] * w; a8[1] += s0[1] * w; a8[2] += s0[2] * w; a8[3] += s0[3] * w; a8[4] += s1[0] * w; a8[5] += s1[1] * w; a8[6] += s1[2] * w; a8[7] += s1[3] * w; }
#pragma unroll
            for (int b = 0; b < 8; ++b) red[(wave * 8 + b) * 64 + lane] = a8[b];
            __syncthreads();
            { const int b = wave; float s = I.b_ada[vcu * 64 + lane];
#pragma unroll
              for (int w = 0; w < 8; ++w) s += red[(w * 8 + b) * 64 + lane];
              ADA[(size_t)b * 6144 + vcu * 64 + lane] = s; }
            __syncthreads();
        }
        LAS float* scr = (LAS float*)(lds + RING_OFF + wave * 16384);
        constexpr int I_IN = 16 * 224, I_SQ = 16 * 32, I_RT = 16 * 2, I_DN = 4 * 32;
        constexpr int NIT = I_IN + 3 * I_SQ + I_RT + NEXP1 * I_DN;
        for (int it = gw; it < NIT; it += NGW) {
            int r = it;
            if (r < I_IN) { transpose_item(I.w_in, DIN, 64 * (r / 224), 32 * (r % 224), WIN, 1024, 32 * (r % 224), 0, scr, lane); continue; } r -= I_IN;
            if (r < I_SQ) { transpose_item(I.p_rnn, 1024, 64 * (r / 32), 32 * (r % 32), WBR, 2048, 32 * (r % 32), 0, scr, lane); continue; } r -= I_SQ;
            if (r < I_SQ) { transpose_item(I.p_attn, 1024, 64 * (r / 32), 32 * (r % 32), WBR, 2048, 32 * (r % 32), 1024, scr, lane); continue; } r -= I_SQ;
            if (r < I_SQ) { transpose_item(I.w_out, 1024, 64 * (r / 32), 32 * (r % 32), WOUT, 1024, 32 * (r % 32), 0, scr, lane); continue; } r -= I_SQ;
            if (r < I_RT) { transpose_item(I.w_router, 64, 64 * (r / 2), 32 * (r % 2), WRTR, 1024, 32 * (r % 2), 0, scr, lane); continue; } r -= I_RT;
            { const int e = r / I_DN, q = r % I_DN; const float* src = (e < NEXP) ? I.we_down + (size_t)e * 256 * 1024 : I.ws_down;
              transpose_item(src, 1024, 64 * (q / 32), 32 * (q % 32), W2 + (size_t)e * 1024 * 256, 256, 32 * (q % 32), 0, scr, lane); }
        }
        for (int i = gw * 64 + lane; i < 192 * 1024 / 8; i += NGW * 64) *(u32x4*)(WRTR + 64 * 1024 + (size_t)i * 8) = (u32x4){0u, 0u, 0u, 0u};
    }
    SEAM(0);

    if (IN(1)) {
        for (int m = gw; m < M; m += NGW) {
            const float* ada = ADA + (size_t)(m / SEQ) * 6144;
            const GAS f32x4* xr = (const GAS f32x4*)(I.x + (size_t)m * DM) + lane;
            f32x4 v[4]; float s = 0.f;
#pragma unroll
            for (int j = 0; j < 4; ++j) { v[j] = xr[64 * j]; s += (v[j].x + v[j].y) + (v[j].z + v[j].w); }
            const float mean = wave_sum(s) * (1.f / DM); float s2 = 0.f;
#pragma unroll
            for (int j = 0; j < 4; ++j) { v[j] = v[j] - mean; s2 += (v[j].x * v[j].x + v[j].y * v[j].y) + (v[j].z * v[j].z + v[j].w * v[j].w); }
            const float rstd = 1.f / sqrtf(wave_sum(s2) * (1.f / DM) + LN_EPS);
            GAS u32x2* o8 = (GAS u32x2*)(HB + (size_t)m * DM) + lane;
#pragma unroll
            for (int j = 0; j < 4; ++j) { const f32x4 sh = *((const f32x4*)ada + lane + 64 * j), sc = *((const f32x4*)(ada + 1024) + lane + 64 * j);
                const f32x4 y = v[j] * rstd * (sc + 1.0f) + sh; o8[64 * j] = (u32x2){pk2(y.x, y.y), pk2(y.z, y.w)}; }
        }
    }
    SEAM(1);

    if (IN(2)) {
        pg8::Gemm g{HB, WIN, 1024, 1 << 30, 0}; pg8::DenseSched S; S.init(M, DIN, 1024, G, bx, 2048u);
        pg8::EpiInProj E{XR, YG, QB, KB, VB, GB};
        pg8::gemm_phase<pg8::EpiInProj, pg8::DenseSched, true>(lds + RING_OFF, g, S, E);
    }
    SEAM(2);

    if (IN(3)) {
        for (int u = vcu; u < 256; u += G) rg::rglru_unit(u >> 5, (u >> 1) & 15, u & 1, XR, YG, I.conv_w, I.conv_b, I.lru_w_a, I.lru_b_a, I.lru_w_i, I.lru_b_i, I.lru_lambda, lds + RING_OFF);
        const float s1 = wave_sum(I.lam_q1[lane] * I.lam_k1[lane]), s2 = wave_sum(I.lam_q2[lane] * I.lam_k2[lane]);
        const float lam = expf(s1) - expf(s2) + LAM_INIT;
        for (int v = vcu; v < 256; v += G) { const int bh = v >> 2, j = v & 3;
#pragma unroll 1
            for (int i = 0; i < 4; ++i) { const int qb = (i == 0) ? 15 - j : (i == 1) ? 8 + j : (i == 2) ? 7 - j : j;
                att::attn_unit(bh >> 3, bh & 7, qb, QB, KB, VB, QB, lds + RING_OFF, lam, I.subln_g); } }
    }
    SEAM(3);

    if (IN(4)) {
        pg8::Gemm g{YG, WBR, 2048, 16, (long)(WS_Q - WS_YG) - 16 * 128}; pg8::DenseSched S; S.init(M, 1024, 2048, G, bx, 2048u);
        pg8::EpiBranch E{GB, MRG};
        pg8::gemm_phase<pg8::EpiBranch, pg8::DenseSched, true>(lds + RING_OFF, g, S, E);
    }
    SEAM(4);

    if (IN(5)) {
        pg8::Gemm g{MRG, WOUT, 1024, 1 << 30, 0}; pg8::DenseSched S; S.init(M, 1024, 1024, G, bx, 2048u);
        pg8::EpiOutProj E{I.x, ADA, OUT};
        pg8::gemm_phase<pg8::EpiOutProj, pg8::DenseSched, true>(lds + RING_OFF, g, S, E);
    }
    SEAM(5);

    if (IN(6)) {
        for (int m = gw; m < M; m += NGW) {
            const float* ada = ADA + (size_t)(m / SEQ) * 6144;
            GAS f32x4* xr = (GAS f32x4*)(OUT + (size_t)m * DM) + lane;
            f32x4 v[4]; float s = 0.f;
#pragma unroll
            for (int j = 0; j < 4; ++j) { v[j] = xr[64 * j]; s += (v[j].x + v[j].y) + (v[j].z + v[j].w); }
            float mean = wave_sum(s) * (1.f / DM), s2 = 0.f;
#pragma unroll
            for (int j = 0; j < 4; ++j) { v[j] = v[j] - mean; s2 += (v[j].x * v[j].x + v[j].y * v[j].y) + (v[j].z * v[j].z + v[j].w * v[j].w); }
            float rstd = 1.f / sqrtf(wave_sum(s2) * (1.f / DM) + LN_EPS);
            s = 0.f;
#pragma unroll
            for (int j = 0; j < 4; ++j) { const f32x4 gg = *((const f32x4*)I.ln1_g + lane + 64 * j), bb = *((const f32x4*)I.ln1_b + lane + 64 * j);
                v[j] = v[j] * rstd * gg + bb; xr[64 * j] = v[j]; s += (v[j].x + v[j].y) + (v[j].z + v[j].w); }
            mean = wave_sum(s) * (1.f / DM); s2 = 0.f;
#pragma unroll
            for (int j = 0; j < 4; ++j) { v[j] = v[j] - mean; s2 += (v[j].x * v[j].x + v[j].y * v[j].y) + (v[j].z * v[j].z + v[j].w * v[j].w); }
            rstd = 1.f / sqrtf(wave_sum(s2) * (1.f / DM) + LN_EPS);
            GAS u32x2* o8 = (GAS u32x2*)(UB + (size_t)m * DM) + lane;
#pragma unroll
            for (int j = 0; j < 4; ++j) { const f32x4 sh = *((const f32x4*)(ada + 3072) + lane + 64 * j), sc = *((const f32x4*)(ada + 4096) + lane + 64 * j);
                const f32x4 y = v[j] * rstd * (sc + 1.0f) + sh; o8[64 * j] = (u32x2){pk2(y.x, y.y), pk2(y.z, y.w)}; }
        }
    }
    SEAM(6);

    if (IN(7)) {
        { pg8::Gemm g{UB, WRTR, 1024, 1 << 30, 0}; pg8::DenseSched S; S.init(M, 256, 1024, G, bx, 2048u);
          pg8::EpiRouter E{LOGITS};
          pg8::gemm_phase<pg8::EpiRouter, pg8::DenseSched, true>(lds + RING_OFF, g, S, E); }
        __syncthreads();
        LAS float* scr = (LAS float*)(lds + RING_OFF + wave * 16384);
        constexpr int I_GU = 16 * 8, NIT = NEXP1 * 2 * I_GU;
        for (int it = gw; it < NIT; it += NGW) { const int e = it / (2 * I_GU), r = it % (2 * I_GU), up = r / I_GU, q = r % I_GU, n0 = 32 * (q % 8);
            const float* src = (e < NEXP) ? (up ? I.we_up : I.we_gate) + (size_t)e * 1024 * 256 : (up ? I.ws_up : I.ws_gate);
            transpose_item(src, 256, 64 * (q / 8), n0, W1 + (size_t)e * 512 * 1024, 1024, (n0 >> 7) * 256 + up * 128 + (n0 & 127), 0, scr, lane); }
    }
    SEAM(7);

    if (IN(8)) {
        LAS float* sl = (LAS float*)(lds + RING_OFF);
        LAS float* sv = sl + 64 * 65;
        LAS unsigned* hist = (LAS unsigned*)(sv + 64 * 65);
        LAS unsigned* base = hist + 64;
        for (int tg = vcu; tg < M / 64; tg += G) {
            for (int i = tid; i < 64 * 64; i += NWAVES * 64) { const int t = i >> 6, e = i & 63; const float s = fast_sigmoid(LOGITS[(size_t)(tg * 64 + t) * 64 + e]); sv[t * 65 + e] = s; sl[t * 65 + e] = s + I.router_bias[e]; }
            if (tid < 64) hist[tid] = 0u;
            __syncthreads();
            if (wave == 0) {
                const LAS float* ms = sl + lane * 65; const LAS float* mv = sv + lane * 65;
                float gs[8];
#pragma unroll
                for (int g = 0; g < 8; ++g) { float t1 = -INFINITY, t2 = -INFINITY;
#pragma unroll
                    for (int j = 0; j < 8; ++j) { const float x = ms[g * 8 + j]; if (x > t1) { t2 = t1; t1 = x; } else if (x > t2) t2 = x; }
                    gs[g] = t1 + t2; }
                unsigned gmask = 0u;
#pragma unroll
                for (int r = 0; r < 4; ++r) { float best = -INFINITY; int bi = 0;
#pragma unroll
                    for (int g = 0; g < 8; ++g) { const bool ok = !((gmask >> g) & 1u) && gs[g] > best; best = ok ? gs[g] : best; bi = ok ? g : bi; }
                    gmask |= 1u << bi; }
                unsigned long long picked = 0ull; int ei[8]; float wv[8]; float wsum = 0.f;
#pragma unroll
                for (int r = 0; r < 8; ++r) { float best = -INFINITY; int bi = 0;
                    for (int e = 0; e < 64; ++e) { const float x = ms[e]; const bool ok = ((gmask >> (e >> 3)) & 1u) && !((picked >> e) & 1ull) && x > best; best = ok ? x : best; bi = ok ? e : bi; }
                    picked |= 1ull << bi; ei[r] = bi; wv[r] = mv[bi]; wsum += wv[r]; }
                const float wn = 2.5f / wsum; const unsigned tok = (unsigned)(tg * 64 + lane); unsigned pos[8];
#pragma unroll
                for (int r = 0; r < 8; ++r) { pos[r] = atomicAdd((unsigned*)&hist[ei[r]], 1u); TOKW[(size_t)tok * 8 + r] = wv[r] * wn; }
                LDS_WAIT();
                { const unsigned hc = hist[lane]; base[lane] = hc ? __hip_atomic_fetch_add(ctl + CW_CNT + 64 * lane, hc, RLX_AGENT) : 0u; }
                LDS_WAIT();
#pragma unroll
                for (int r = 0; r < 8; ++r) LIST[(size_t)ei[r] * M + base[ei[r]] + pos[r]] = tok * 16u + (unsigned)r;
            }
            __syncthreads();
        }
    }
    SEAM(8);

    pg8::ExpertTables ET; ET.tp = (const LAS int*)(lds + TAB_TP); ET.cnt = (const LAS int*)(lds + TAB_CNT); ET.rt2e = (const LAS unsigned char*)(lds + TAB_RT2E); ET.RT = 0;
    if (hi > 9) {
        LAS int* tp = (LAS int*)(lds + TAB_TP); LAS int* cn = (LAS int*)(lds + TAB_CNT); LAS unsigned char* r2e = (LAS unsigned char*)(lds + TAB_RT2E);
        if (tid < NEXP1) cn[tid] = (tid < NEXP) ? (int)__hip_atomic_load(ctl + CW_CNT + 64 * tid, RLX_AGENT) : M;
        __syncthreads();
        if (tid == 0) { int acc = 0; for (int e = 0; e < NEXP1; ++e) { tp[e] = acc; acc += (cn[e] + 255) >> 8; } tp[NEXP1] = acc; }
        __syncthreads();
        const int RT = tp[NEXP1];
        for (int e = wave; e < NEXP1; e += NWAVES) for (int rt = tp[e] + lane; rt < tp[e + 1]; rt += 64) r2e[rt] = (unsigned char)e;
        __syncthreads();
        ET.RT = RT;
    }

    if (IN(9)) {
        pg8::Gemm g{UB, W1, 1024, 1 << 30, 0};
        pg8::ExpertSched S; S.T = ET; S.nN = 2; S.G = G; S.c = bx; S.list = LIST; S.mode = 0; S.bstride = W1_STRIDE; S.bsub = 256 * 1024 * 2; S.pn0 = 0;
        pg8::EpiGemm1 E{ET, LIST, TOKW, HX};
        pg8::gemm_phase<pg8::EpiGemm1, pg8::ExpertSched, true>(lds + RING_OFF, g, S, E);
    }
    SEAM(9);

#pragma unroll 1
    for (int half = 0; half < 2; ++half) {
        if (IN(10 + 2 * half)) {
            pg8::Gemm g{HX, W2, 256, 1 << 30, 0};
            pg8::ExpertSched S; S.T = ET; S.nN = 2; S.G = G; S.c = bx; S.list = LIST; S.mode = 1; S.bstride = W2_STRIDE; S.bsub = 256 * 256 * 2; S.pn0 = 2 * half;
            pg8::EpiGemm2 E{LIST, YS};
            pg8::gemm_phase<pg8::EpiGemm2, pg8::ExpertSched, true>(lds + RING_OFF, g, S, E);
        }
        SEAM(10 + 2 * half);
        if (IN(11 + 2 * half)) {
            for (int m = gw; m < M; m += NGW) {
                const float* ada = ADA + (size_t)(m / SEQ) * 6144;
                float a[8];
#pragma unroll
                for (int j = 0; j < 8; ++j) a[j] = 0.f;
#pragma unroll
                for (int k = 0; k < NSLOTK; ++k) { const u32x4 y = *(const u32x4*)(YS + ((size_t)m * NSLOTK + k) * 512 + lane * 8);
#pragma unroll
                    for (int q = 0; q < 4; ++q) { a[2 * q] += bf_lo(y[q]); a[2 * q + 1] += bf_hi(y[q]); } }
                float* op = OUT + (size_t)m * DM + half * 512 + lane * 8; const float* g2 = ada + 5120 + half * 512 + lane * 8;
                f32x4 x0 = *(const f32x4*)op, x1 = *(const f32x4*)(op + 4); const f32x4 ga = *(const f32x4*)g2, gb = *(const f32x4*)(g2 + 4);
                x0 = x0 * ALPHA_DN + ga * (f32x4){a[0], a[1], a[2], a[3]}; x1 = x1 * ALPHA_DN + gb * (f32x4){a[4], a[5], a[6], a[7]};
                if (half == 0) { *(f32x4*)op = x0; *(f32x4*)(op + 4) = x1; }
                else { const float* pp = OUT + (size_t)m * DM + lane * 8; f32x4 p0 = *(const f32x4*)pp, p1 = *(const f32x4*)(pp + 4);
                    float s = (p0.x + p0.y) + (p0.z + p0.w) + (p1.x + p1.y) + (p1.z + p1.w) + (x0.x + x0.y) + (x0.z + x0.w) + (x1.x + x1.y) + (x1.z + x1.w);
                    const float mean = wave_sum(s) * (1.f / DM); p0 = p0 - mean; p1 = p1 - mean; x0 = x0 - mean; x1 = x1 - mean;
                    float s2 = (p0.x * p0.x + p0.y * p0.y) + (p0.z * p0.z + p0.w * p0.w) + (p1.x * p1.x + p1.y * p1.y) + (p1.z * p1.z + p1.w * p1.w)
                             + (x0.x * x0.x + x0.y * x0.y) + (x0.z * x0.z + x0.w * x0.w) + (x1.x * x1.x + x1.y * x1.y) + (x1.z * x1.z + x1.w * x1.w);
                    const float rstd = 1.f / sqrtf(wave_sum(s2) * (1.f / DM) + LN_EPS);
                    const float* lg = I.ln2_g + lane * 8; const float* lb = I.ln2_b + lane * 8;
                    *(f32x4*)pp = p0 * rstd * *(const f32x4*)lg + *(const f32x4*)lb; *(f32x4*)(pp + 4) = p1 * rstd * *(const f32x4*)(lg + 4) + *(const f32x4*)(lb + 4);
                    *(f32x4*)op = x0 * rstd * *(const f32x4*)(lg + 512) + *(const f32x4*)(lb + 512); *(f32x4*)(op + 4) = x1 * rstd * *(const f32x4*)(lg + 516) + *(const f32x4*)(lb + 516); }
            }
        }
        if (half == 0) SEAM(11);
    }
#undef IN
#undef SEAM
}

extern "C" void kernel_launch(void* const* d_in, const int* in_sizes, int n_in, void* d_out, int out_size, void* d_ws, size_t ws_size, hipStream_t stream) {
    static int grid = 0;
    if (grid == 0) {
        if (n_in != 32 || in_sizes[0] != M * DM || out_size != M * DM || ws_size < WS_END) { fprintf(stderr, "kernel_launch: unexpected shapes / workspace (n_in %d, ws %zu < %zu); nothing launched\n", n_in, ws_size, (size_t)WS_END); grid = -1; return; }
        int dev = 0, cus = 0, per_cu = 0;
        if (hipGetDevice(&dev) != hipSuccess || hipDeviceGetAttribute(&cus, hipDeviceAttributeMultiprocessorCount, dev) != hipSuccess) { grid = -1; return; }
        if (hipFuncSetAttribute((const void*)mk_fwd, hipFuncAttributeMaxDynamicSharedMemorySize, LDS_BYTES) != hipSuccess) { fprintf(stderr, "kernel_launch: hipFuncSetAttribute failed\n"); grid = -1; return; }
        if (hipOccupancyMaxActiveBlocksPerMultiprocessor(&per_cu, (const void*)mk_fwd, NWAVES * 64, LDS_BYTES) != hipSuccess || per_cu < 1) { fprintf(stderr, "kernel_launch: occupancy query reports %d\n", per_cu); }
        (void)hipGetLastError();
        grid = cus;
    }
    if (grid < 0) return;
    (void)hipMemsetAsync((char*)d_ws + WS_CTL, 0, CTL_ZERO_BYTES, stream);
    Args a{};
    const float** ip = (const float**)&a.in;
    for (int i = 0; i < 32; ++i) ip[i] = (const float*)d_in[i];
    a.out = (float*)d_out; a.ws = (unsigned char*)d_ws;
    if (MK_N_LAUNCHES == 1) { a.ph_lo = 0; a.ph_hi = N_PHASES; a.li = 0; hipLaunchKernelGGL(mk_fwd, dim3(grid), dim3(NWAVES * 64), LDS_BYTES, stream, a); }
    else for (int p = 0; p < N_PHASES; ++p) { a.ph_lo = p; a.ph_hi = p + 1; a.li = p; hipLaunchKernelGGL(mk_fwd, dim3(grid), dim3(NWAVES * 64), LDS_BYTES, stream, a); }
}
```

```cpp
#define MK_N_LAUNCHES 1
#include <hip/hip_runtime.h>
#include <cstdio>
#include <cstdint>

#define LAS __attribute__((address_space(3)))
#define GAS __attribute__((address_space(1)))
typedef unsigned short bf16_t;
typedef short bf16x8 __attribute__((ext_vector_type(8)));
typedef short s16x4 __attribute__((ext_vector_type(4)));
typedef float f32x4 __attribute__((ext_vector_type(4)));
typedef float f32x2 __attribute__((ext_vector_type(2)));
typedef float f32x16 __attribute__((ext_vector_type(16)));
typedef unsigned u32x4 __attribute__((ext_vector_type(4)));
typedef unsigned u32x2 __attribute__((ext_vector_type(2)));

constexpr int BATCH = 8, SEQ = 2048, DM = 1024, M = BATCH * SEQ, DIN = 7168;
constexpr int NEXP = 64, NEXP1 = 65  , TOPK = 8, DEXP = 256, NSLOTK = 9  ;
constexpr float ALPHA_DN = 1.189207115002721f;
constexpr float LN_EPS = 1e-5f, RMS_EPS = 1e-5f;
constexpr float LOG2E = 1.4426950408889634f;
constexpr float QSCALE = 0.125f * LOG2E;
constexpr float LAM_INIT = 0.2f;

__device__ __forceinline__ unsigned f2bf(float f) { unsigned u = __builtin_bit_cast(unsigned, f); return (u + 0x7fffu + ((u >> 16) & 1u)) >> 16; }
typedef __bf16 hwbf16x2 __attribute__((ext_vector_type(2)));
__device__ __forceinline__ unsigned pk2(float lo, float hi) { const f32x2 v = {lo, hi}; return __builtin_bit_cast(unsigned, __builtin_convertvector(v, hwbf16x2)); }
__device__ __forceinline__ float bf_lo(unsigned w) { return __builtin_bit_cast(float, w << 16); }
__device__ __forceinline__ float bf_hi(unsigned w) { return __builtin_bit_cast(float, w & 0xffff0000u); }
__device__ __forceinline__ float fast_sigmoid(float x) { return __builtin_amdgcn_rcpf(1.0f + __builtin_amdgcn_exp2f(-x * LOG2E)); }
__device__ __forceinline__ float gelu_tanh(float x) { const float z = 1.5957691216057308f * (x + 0.044715f * x * x * x); return x * __builtin_amdgcn_rcpf(1.0f + __builtin_amdgcn_exp2f(-z * LOG2E)); }

namespace pg8 {
constexpr int BM = 256, BK = 64, HALF = 128, HTB = HALF * BK * 2  , STAGE_BYTES = 8 * HTB, NXCD = 8, WGM = 8;

__host__ __device__ __forceinline__ int lds_byte(int r, int c) { const int st = (r >> 4) * 2 + (c >> 5), rr = r & 15, cc = c & 31, ob = rr * 64 + cc * 2; return st * 1024 + (ob ^ (((ob >> 9) & 1) << 5)); }
__host__ __device__ __forceinline__ void stage_rc(int b, int& R, int& C) { const int st = b / 1024, sb = b % 1024, swz = sb ^ (((sb >> 9) & 1) << 5); R = (st >> 1) * 16 + swz / 64; C = (st & 1) * 32 + (swz % 64) / 2; }
__host__ __device__ __forceinline__ int perm32(int rho) { const int n = rho >> 4, i = rho & 15; return 8 * (i >> 2) + 4 * n + (i & 3); }

struct Unit { int pm, pn, e, nrows; };
struct Gemm { const bf16_t* A; const bf16_t* Bt; int K; int ksplit; long a2delta; };

template <class Epi, class Sched, bool ALIGN_EPI>
__device__ __forceinline__ void gemm_phase(LAS unsigned char* lds, const Gemm g, const Sched& S, const Epi& E) {
    const int tid = threadIdx.x, wid = __builtin_amdgcn_readfirstlane(tid >> 6), lane = tid & 63, wr = wid >> 2, wc = wid & 3, fr = lane & 15, fq = lane >> 4;
    const int K = g.K, nt = K / BK;
    int RA[2]; unsigned CA[2], voffB[2];
#pragma unroll
    for (int i = 0; i < 2; ++i) { int R, C; stage_rc(tid * 16 + i * 8192, R, C); const int Rb = (R & ~31) + perm32(R & 31);
        RA[i] = R; CA[i] = (unsigned)C * 2u; voffB[i] = (unsigned)(Rb * K + C) * 2u; }
    const size_t kstep = (size_t)(BK * 2);
    const size_t hstepB = (size_t)HALF * K * 2;
    const unsigned ldsw = (unsigned)wid * 1024u;
    const int aoff = lds_byte(wr * 64 + fr, fq * 8), boff = lds_byte(wc * 32 + fr, fq * 8);
#define PG8_SA(b, h) (((b) * 2 + (h)) * HTB)
#define PG8_SB(b, h) ((4 + (b) * 2 + (h)) * HTB)
#define PG8_STAGE_B(bufoff, gbase) do { _Pragma("unroll") for (int _i = 0; _i < 2; ++_i) \
        __builtin_amdgcn_global_load_lds((const unsigned*)((const char*)(gbase) + voffB[_i]), (LAS unsigned*)(lds + (bufoff) + ldsw + _i * 8192), 16, 0, 0); } while (0)
#define PG8_STAGE_A(bufoff, gbase, offs) do { _Pragma("unroll") for (int _i = 0; _i < 2; ++_i) \
        __builtin_amdgcn_global_load_lds((const unsigned*)((const char*)(gbase) + (offs)[_i]), (LAS unsigned*)(lds + (bufoff) + ldsw + _i * 8192), 16, 0, 0); } while (0)
#define PG8_LDA(dst, b, h) do { _Pragma("unroll") for (int m = 0; m < 4; ++m) _Pragma("unroll") for (int k = 0; k < 2; ++k) dst[m][k] = *(const LAS bf16x8*)(lds + PG8_SA(b, h) + aoff + m * 2048 + k * 1024); } while (0)
#define PG8_LDB(dst, b, h) do { _Pragma("unroll") for (int n = 0; n < 2; ++n) _Pragma("unroll") for (int k = 0; k < 2; ++k) dst[n][k] = *(const LAS bf16x8*)(lds + PG8_SB(b, h) + boff + n * 2048 + k * 1024); } while (0)
#define PG8_MMA(ai, bj, At, Bt) do { __builtin_amdgcn_s_setprio(1); _Pragma("unroll") for (int m = 0; m < 4; ++m) _Pragma("unroll") for (int n = 0; n < 2; ++n) _Pragma("unroll") for (int k = 0; k < 2; ++k) \
        acc[ai][bj][m][n] = __builtin_amdgcn_mfma_f32_16x16x32_bf16(Bt[n][k], At[m][k], acc[ai][bj][m][n], 0, 0, 0); __builtin_amdgcn_s_setprio(0); } while (0)
#define PG8_WAIT_V(n) asm volatile("s_waitcnt vmcnt(" #n ")" ::: "memory")
#define PG8_WAIT_L(n) asm volatile("s_waitcnt lgkmcnt(" #n ")" ::: "memory")
#define PG8_BAR __builtin_amdgcn_s_barrier()
#define PG8_SCHED __builtin_amdgcn_sched_barrier(0)
    Unit cur, nxt; int ui = 0;
    if (!S.next(0, cur)) return;
    unsigned so0[2], so1[2], no0[2], no1[2];
#pragma unroll
    for (int i = 0; i < 2; ++i) { so0[i] = S.a_off(cur, RA[i]) + CA[i]; so1[i] = S.a_off(cur, HALF + RA[i]) + CA[i]; }
    f32x4 acc[2][2][4][2];
#pragma unroll
    for (int a = 0; a < 2; ++a)
#pragma unroll
        for (int b = 0; b < 2; ++b)
#pragma unroll
            for (int m = 0; m < 4; ++m)
#pragma unroll
                for (int n = 0; n < 2; ++n) acc[a][b][m][n] = (f32x4){0.f, 0.f, 0.f, 0.f};
    bf16x8 At[4][2], B0[2][2], B1[2][2];
    const char* Ab = (const char*)g.A;
    const int ksplit = g.ksplit; const long a2d = g.a2delta;
#define PG8_KA(tt) (Ab + (size_t)(tt) * kstep + ((tt) >= ksplit ? a2d : 0l))
    const char* cB = (const char*)g.Bt + S.b_off(cur);
    { const char* a0 = PG8_KA(0); const char* a1 = PG8_KA(1);
      PG8_STAGE_B(PG8_SB(0, 0), cB); PG8_STAGE_B(PG8_SB(0, 1), cB + hstepB); PG8_STAGE_A(PG8_SA(0, 0), a0, so0); PG8_STAGE_A(PG8_SA(0, 1), a0, so1);
      if (wr == 1) PG8_BAR;
      PG8_WAIT_V(2); PG8_BAR;
      PG8_STAGE_B(PG8_SB(1, 0), cB + kstep); PG8_STAGE_A(PG8_SA(1, 0), a1, so0); PG8_STAGE_B(PG8_SB(1, 1), cB + hstepB + kstep);
      PG8_WAIT_V(6); PG8_BAR; }
    for (;;) {
        const bool has_next = S.next(ui + 1, nxt);
        if (has_next) {
#pragma unroll
            for (int i = 0; i < 2; ++i) { no0[i] = S.a_off(nxt, RA[i]) + CA[i]; no1[i] = S.a_off(nxt, HALF + RA[i]) + CA[i]; }
        } else {
#pragma unroll
            for (int i = 0; i < 2; ++i) { no0[i] = so0[i]; no1[i] = so1[i]; }
        }
        const char* nB = has_next ? (const char*)g.Bt + S.b_off(nxt) : cB;
        for (int t = 0; t < nt; t += 2) {
            const bool last = (t == nt - 2);
            if constexpr (Epi::HAS_MID) { if (t == (nt >> 1)) E.mid(acc, cur, wr, wc, fr, fq); }
            const char* a1 = PG8_KA(t + 1);
            const int t2 = last ? 0 : t + 2;
            const char* a2 = PG8_KA(t2); const char* a3 = PG8_KA(t2 + 1);
            const char* b2 = last ? nB : cB + (size_t)(t + 2) * kstep; const char* b3 = b2 + kstep;
            PG8_LDB(B0, 0, 0); PG8_LDB(B1, 0, 1); PG8_SCHED; PG8_LDA(At, 0, 0); PG8_STAGE_A(PG8_SA(1, 1), a1, so1);
            if (last) {
#pragma unroll
                for (int i = 0; i < 2; ++i) { so0[i] = no0[i]; so1[i] = no1[i]; }
            }
            PG8_WAIT_V(8); PG8_WAIT_L(0); PG8_BAR; PG8_MMA(0, 0, At, B0); PG8_MMA(0, 1, At, B1); PG8_BAR; PG8_SCHED;
            PG8_LDA(At, 0, 1); PG8_STAGE_B(PG8_SB(0, 0), b2); PG8_STAGE_B(PG8_SB(0, 1), b2 + hstepB); PG8_STAGE_A(PG8_SA(0, 0), a2, so0);
            PG8_WAIT_V(8); PG8_WAIT_L(0); PG8_BAR; PG8_MMA(1, 0, At, B0); PG8_MMA(1, 1, At, B1); PG8_BAR; PG8_SCHED;
            PG8_LDB(B0, 1, 0); PG8_LDB(B1, 1, 1); PG8_SCHED; PG8_LDA(At, 1, 0); PG8_STAGE_A(PG8_SA(0, 1), a2, so1);
            PG8_WAIT_V(8); PG8_WAIT_L(0); PG8_BAR; PG8_MMA(0, 0, At, B0); PG8_MMA(0, 1, At, B1); PG8_BAR; PG8_SCHED;
            PG8_LDA(At, 1, 1); PG8_STAGE_B(PG8_SB(1, 0), b3); PG8_STAGE_B(PG8_SB(1, 1), b3 + hstepB); PG8_STAGE_A(PG8_SA(1, 0), a3, so0);
            PG8_WAIT_V(8); PG8_WAIT_L(0); PG8_BAR; PG8_MMA(1, 0, At, B0); PG8_MMA(1, 1, At, B1); PG8_BAR; PG8_SCHED;
        }
        if constexpr (ALIGN_EPI) { if (wr == 0) PG8_BAR; }
        E(acc, cur, wr, wc, fr, fq);
        if (!has_next) break;
#pragma unroll
        for (int a = 0; a < 2; ++a)
#pragma unroll
            for (int b = 0; b < 2; ++b)
#pragma unroll
                for (int m = 0; m < 4; ++m)
#pragma unroll
                    for (int n = 0; n < 2; ++n) acc[a][b][m][n] = (f32x4){0.f, 0.f, 0.f, 0.f};
        cur = nxt; cB = nB; ++ui;
        if constexpr (ALIGN_EPI) { if (wr == 1) PG8_BAR; }
    }
    PG8_WAIT_V(0);
    if constexpr (!ALIGN_EPI) { if (wr == 0) PG8_BAR; }
    PG8_BAR;
#undef PG8_SA
#undef PG8_SB
#undef PG8_STAGE_A
#undef PG8_STAGE_B
#undef PG8_LDA
#undef PG8_LDB
#undef PG8_MMA
#undef PG8_WAIT_V
#undef PG8_WAIT_L
#undef PG8_BAR
#undef PG8_SCHED
#undef PG8_KA
}

struct DenseSched {
    int nM, nN, nwg, G, c; unsigned lda_bytes; int Kb;
    __device__ void init(int M_, int N_, int K_, int G_, int c_, unsigned lda_bytes_) { nM = M_ / BM; nN = N_ / BM; nwg = nM * nN; G = G_; c = c_; lda_bytes = lda_bytes_; Kb = K_ * 2; }
    __device__ __forceinline__ bool next(int i, Unit& u) const {
        const long L = (long)i * G + c; if (L >= nwg) return false;
        int wgid = (int)L; { const int q = nwg / NXCD, r = nwg % NXCD, xcd = wgid % NXCD, off = wgid / NXCD; wgid = (xcd < r ? xcd * (q + 1) : r * (q + 1) + (xcd - r) * q) + off; }
        const int nig = WGM * nN, gid = wgid / nig, fm = gid * WGM, gsz = (nM - fm) < WGM ? (nM - fm) : WGM;
        u.pm = fm + ((wgid % nig) % gsz); u.pn = (wgid % nig) / gsz; u.e = 0; u.nrows = BM; return true;
    }
    __device__ __forceinline__ unsigned a_off(const Unit& u, int r) const { return (unsigned)(u.pm * BM + r) * lda_bytes; }
    __device__ __forceinline__ size_t b_off(const Unit& u) const { return (size_t)u.pn * BM * (size_t)Kb; }
};
}

constexpr size_t MiB = 1u << 20;
constexpr size_t WS_CTL = 0, CTL_ZERO_BYTES = 1 * MiB;
constexpr size_t WS_ADA = 1 * MiB;
constexpr size_t WS_WIN = 2 * MiB;
constexpr size_t WS_WBR = 16 * MiB;
constexpr size_t WS_WOUT = 20 * MiB;
constexpr size_t WS_WRTR = 22 * MiB;
constexpr size_t WS_W2 = 23 * MiB;
constexpr size_t WS_HB = 56 * MiB;
constexpr size_t WS_XR = 88 * MiB;
constexpr size_t WS_YG = 120 * MiB;
constexpr size_t WS_Q = 152 * MiB;
constexpr size_t WS_K = 184 * MiB;
constexpr size_t WS_V = 216 * MiB;
constexpr size_t WS_G = 248 * MiB;
constexpr size_t WS_LOG = 56 * MiB;
constexpr size_t WS_LIST = 60 * MiB;
constexpr size_t WS_TOKW = 64 * MiB;
constexpr size_t WS_H = 68 * MiB;
constexpr size_t WS_Y = 149 * MiB;
constexpr size_t WS_U = 149 * MiB;
constexpr size_t WS_W1 = 181 * MiB;
constexpr size_t WS_END = 312 * MiB;
constexpr size_t W1_STRIDE = 512 * 1024 * 2, W2_STRIDE = 1024 * 256 * 2;
constexpr int CW_TMO = 0, CW_CODE = 1, CW_BAR = 4096, CW_CNT = 16384  ;

namespace pg8 {

struct EpiInProj {
    static constexpr bool HAS_MID = false;
    bf16_t *XR, *YG, *Q, *Kb, *V, *G;
    __device__ __forceinline__ void mid(f32x4 (&)[2][2][4][2], const Unit&, int, int, int, int) const {}
    __device__ __forceinline__ void operator()(const f32x4 (&acc)[2][2][4][2], const Unit& u, int wr, int wc, int fr, int fq) const {
        const int sec = u.pn >> 2;
        bf16_t* base; int ldc = 1024, colt = (u.pn & 3) * 256, act = 0;
        if (sec == 0) base = XR; else if (sec == 1) { base = YG; act = 1; } else if (sec == 2) { base = Q; act = 2; } else if (sec == 3) base = Kb; else if (sec == 4) base = V;
        else { base = G; ldc = 2048; colt = (u.pn - 20) * 256; act = 3; }
        const int row0 = u.pm * BM + wr * 64 + fr, col0 = colt + wc * 32 + 8 * fq;
#pragma unroll
        for (int ai = 0; ai < 2; ++ai)
#pragma unroll
            for (int m = 0; m < 4; ++m) { bf16_t* rowp = base + (size_t)(row0 + ai * HALF + m * 16) * ldc + col0;
#pragma unroll
                for (int bj = 0; bj < 2; ++bj) { f32x4 v0 = acc[ai][bj][m][0], v1 = acc[ai][bj][m][1];
                    if (act == 1) {
#pragma unroll
                        for (int j = 0; j < 4; ++j) { v0[j] = gelu_tanh(v0[j]); v1[j] = gelu_tanh(v1[j]); }
                    } else if (act == 2) { v0 = v0 * QSCALE; v1 = v1 * QSCALE; }
                    else if (act == 3) {
#pragma unroll
                        for (int j = 0; j < 4; ++j) { v0[j] = fast_sigmoid(v0[j]); v1[j] = fast_sigmoid(v1[j]); }
                    }
                    u32x4 w; w.x = pk2(v0[0], v0[1]); w.y = pk2(v0[2], v0[3]); w.z = pk2(v1[0], v1[1]); w.w = pk2(v1[2], v1[3]);
                    *(u32x4*)(rowp + bj * HALF) = w; } }
    }
};

struct EpiBranch {
    static constexpr bool HAS_MID = true;
    const bf16_t* G; bf16_t* O;
    __device__ __forceinline__ void mid(f32x4 (&acc)[2][2][4][2], const Unit& u, int wr, int wc, int fr, int fq) const {
        int row0 = u.pm * BM + wr * 64 + fr; const int col0 = u.pn * BM + wc * 32 + 8 * fq;
        asm volatile("" : "+v"(row0));
#pragma unroll
        for (int ai = 0; ai < 2; ++ai)
#pragma unroll
            for (int m = 0; m < 4; ++m) { const bf16_t* gp = G + (size_t)(row0 + ai * HALF + m * 16) * 2048 + col0;
#pragma unroll
                for (int bj = 0; bj < 2; ++bj) { const u32x4 gr = *(const u32x4*)(gp + bj * HALF), ga = *(const u32x4*)(gp + 1024 + bj * HALF);
#pragma unroll
                    for (int q = 0; q < 4; ++q) { const float r0 = bf_lo(gr[q]) * __builtin_amdgcn_rcpf(fmaxf(bf_lo(ga[q]), 1e-20f)), r1 = bf_hi(gr[q]) * __builtin_amdgcn_rcpf(fmaxf(bf_hi(ga[q]), 1e-20f));
                        acc[ai][bj][m][q >> 1][(q & 1) * 2] *= r0; acc[ai][bj][m][q >> 1][(q & 1) * 2 + 1] *= r1; } } }
    }
    __device__ __forceinline__ void operator()(const f32x4 (&acc)[2][2][4][2], const Unit& u, int wr, int wc, int fr, int fq) const {
        const int row0 = u.pm * BM + wr * 64 + fr, col0 = u.pn * BM + wc * 32 + 8 * fq;
#pragma unroll
        for (int ai = 0; ai < 2; ++ai)
#pragma unroll
            for (int m = 0; m < 4; ++m) { const size_t row = (size_t)(row0 + ai * HALF + m * 16);
#pragma unroll
                for (int bj = 0; bj < 2; ++bj) { const u32x4 ga = *(const u32x4*)(G + row * 2048 + 1024 + col0 + bj * HALF); float o[8];
#pragma unroll
                    for (int q = 0; q < 4; ++q) { o[2 * q] = acc[ai][bj][m][q >> 1][(q & 1) * 2] * fmaxf(bf_lo(ga[q]), 1e-20f); o[2 * q + 1] = acc[ai][bj][m][q >> 1][(q & 1) * 2 + 1] * fmaxf(bf_hi(ga[q]), 1e-20f); }
                    u32x4 w; w.x = pk2(o[0], o[1]); w.y = pk2(o[2], o[3]); w.z = pk2(o[4], o[5]); w.w = pk2(o[6], o[7]);
                    *(u32x4*)(O + row * 1024 + col0 + bj * HALF) = w; } }
    }
};

struct EpiOutProj {
    static constexpr bool HAS_MID = false;
    const float* x; const float* ada; float* out;
    __device__ __forceinline__ void mid(f32x4 (&)[2][2][4][2], const Unit&, int, int, int, int) const {}
    __device__ __forceinline__ void operator()(const f32x4 (&acc)[2][2][4][2], const Unit& u, int wr, int wc, int fr, int fq) const {
        const int row0 = u.pm * BM + wr * 64 + fr, col0 = u.pn * BM + wc * 32 + 8 * fq;
        const float* g1 = ada + (size_t)((u.pm * BM) / SEQ) * 6144 + 2048;
#pragma unroll
        for (int bj = 0; bj < 2; ++bj) { const f32x4 ga = *(const f32x4*)(g1 + col0 + bj * HALF), gb = *(const f32x4*)(g1 + col0 + bj * HALF + 4);
#pragma unroll
            for (int ai = 0; ai < 2; ++ai)
#pragma unroll
                for (int m = 0; m < 4; ++m) { const size_t off = (size_t)(row0 + ai * HALF + m * 16) * 1024 + col0 + bj * HALF;
                    const f32x4 xa = *(const f32x4*)(x + off), xb = *(const f32x4*)(x + off + 4);
                    *(f32x4*)(out + off) = xa * ALPHA_DN + ga * acc[ai][bj][m][0]; *(f32x4*)(out + off + 4) = xb * ALPHA_DN + gb * acc[ai][bj][m][1]; } }
    }
};

struct EpiRouter {
    static constexpr bool HAS_MID = false;
    float* logits;
    __device__ __forceinline__ void mid(f32x4 (&)[2][2][4][2], const Unit&, int, int, int, int) const {}
    __device__ __forceinline__ void operator()(const f32x4 (&acc)[2][2][4][2], const Unit& u, int wr, int wc, int fr, int fq) const {
        if (wc >= 2) return;
        const int row0 = u.pm * BM + wr * 64 + fr, col0 = wc * 32 + 8 * fq;
#pragma unroll
        for (int ai = 0; ai < 2; ++ai)
#pragma unroll
            for (int m = 0; m < 4; ++m) { float* p = logits + (size_t)(row0 + ai * HALF + m * 16) * 64 + col0; *(f32x4*)p = acc[ai][0][m][0]; *(f32x4*)(p + 4) = acc[ai][0][m][1]; }
    }
};

struct ExpertTables { const LAS int* tp; const LAS int* cnt; const LAS unsigned char* rt2e; int RT; };
struct ExpertSched {
    ExpertTables T; int nN, G, c; const unsigned* list; int mode;
    size_t bstride, bsub;
    int pn0;
    __device__ __forceinline__ bool next(int i, Unit& u) const {
        const long L = (long)i * G + c; if (L >= (long)T.RT * nN) return false;
        const int rt = (int)(L / nN); u.pn = (int)(L % nN); const int e = T.rt2e[rt]; u.e = e; u.pm = rt - T.tp[e];
        const int left = T.cnt[e] - u.pm * BM; u.nrows = left < BM ? left : BM; return true;
    }
    __device__ __forceinline__ unsigned a_off(const Unit& u, int r) const {
        if (mode == 1) return (unsigned)((T.tp[u.e] + u.pm) * BM + r) * 512u;
        const int rr = r < u.nrows ? r : u.nrows - 1; const int slot = u.pm * BM + rr;
        const unsigned tok = (u.e == NEXP) ? (unsigned)slot : (list[(size_t)u.e * M + slot] >> 4);
        return tok * 2048u;
    }
    __device__ __forceinline__ size_t b_off(const Unit& u) const { return (size_t)u.e * bstride + (size_t)(pn0 + u.pn) * bsub; }
};

struct EpiGemm1 {
    static constexpr bool HAS_MID = false;
    ExpertTables T; const unsigned* list; const float* tokw; bf16_t* H;
    __device__ __forceinline__ void mid(f32x4 (&)[2][2][4][2], const Unit&, int, int, int, int) const {}
    __device__ __forceinline__ void operator()(const f32x4 (&acc)[2][2][4][2], const Unit& u, int wr, int wc, int fr, int fq) const {
        const int hrow0 = (T.tp[u.e] + u.pm) * BM, col0 = u.pn * HALF + wc * 32 + 8 * fq;
#pragma unroll
        for (int ai = 0; ai < 2; ++ai)
#pragma unroll
            for (int m = 0; m < 4; ++m) { const int r = ai * HALF + wr * 64 + m * 16 + fr;
                if (r < u.nrows) { float w = 1.f;
                    if (u.e != NEXP) { const unsigned ent = list[(size_t)u.e * M + u.pm * BM + r]; w = tokw[(size_t)(ent >> 4) * 8 + (ent & 15u)]; }
                    float o[8];
#pragma unroll
                    for (int n = 0; n < 2; ++n)
#pragma unroll
                        for (int j = 0; j < 4; ++j) { const float gt = acc[ai][0][m][n][j], up = acc[ai][1][m][n][j]; o[4 * n + j] = gt * fast_sigmoid(gt) * up * w; }
                    u32x4 pw; pw.x = pk2(o[0], o[1]); pw.y = pk2(o[2], o[3]); pw.z = pk2(o[4], o[5]); pw.w = pk2(o[6], o[7]);
                    *(u32x4*)(H + (size_t)(hrow0 + r) * 256 + col0) = pw; } }
    }
};

struct EpiGemm2 {
    static constexpr bool HAS_MID = false;
    const unsigned* list; bf16_t* Y; int nostore;
    __device__ __forceinline__ void mid(f32x4 (&)[2][2][4][2], const Unit&, int, int, int, int) const {}
    __device__ __forceinline__ void operator()(const f32x4 (&acc)[2][2][4][2], const Unit& u, int wr, int wc, int fr, int fq) const {
        if (nostore) return;
        const int col0 = u.pn * BM + wc * 32 + 8 * fq;
#pragma unroll
        for (int ai = 0; ai < 2; ++ai)
#pragma unroll
            for (int m = 0; m < 4; ++m) { const int r = ai * HALF + wr * 64 + m * 16 + fr;
                if (r < u.nrows) { unsigned dst;
                    if (u.e != NEXP) { const unsigned ent = list[(size_t)u.e * M + u.pm * BM + r]; dst = (ent >> 4) * NSLOTK + (ent & 15u); } else dst = (unsigned)(u.pm * BM + r) * NSLOTK + 8u;
                    bf16_t* yp = Y + (size_t)dst * 512 + col0;
#pragma unroll
                    for (int bj = 0; bj < 2; ++bj) { const f32x4 v0 = acc[ai][bj][m][0], v1 = acc[ai][bj][m][1];
                        u32x4 w; w.x = pk2(v0[0], v0[1]); w.y = pk2(v0[2], v0[3]); w.z = pk2(v1[0], v1[1]); w.w = pk2(v1[2], v1[3]);
                        *(u32x4*)(yp + bj * HALF) = w; } } }
    }
};
}

namespace att {
constexpr int SLOT = 32768, KOFF = 0, VOFF = 16384, WSF_OFF = 4 * SLOT  , STG_ROW = 132  , STG_BYTES = 32 * STG_ROW * 4;
__device__ __forceinline__ int crow(int r, int hi) { return (r & 3) + 8 * (r >> 2) + 4 * hi; }
__device__ __forceinline__ float max3f(float a, float b, float c) { return __builtin_fmaxf(__builtin_fmaxf(a, b), c); }
__device__ __forceinline__ s16x4 vtr(const LAS unsigned char* p) { typedef short v4i16_t __attribute__((ext_vector_type(4))); return __builtin_bit_cast(s16x4, __builtin_amdgcn_ds_read_tr16_b64_v4i16((LAS v4i16_t*)p)); }

__device__ __forceinline__ void glds16(const void* gsrc, unsigned lds_dst) { unsigned keep;
    asm volatile("s_mov_b32 %0, m0\n\ts_mov_b32 m0, %2\n\ts_nop 0\n\tglobal_load_lds_dwordx4 %1, off\n\ts_mov_b32 m0, %0" : "=&s"(keep) : "v"(gsrc), "s"(lds_dst) : "memory"); }

__device__ __forceinline__ void attn_unit(int b, int h, int qb, const bf16_t* Qg, const bf16_t* Kg, const bf16_t* Vg, bf16_t* Og, LAS unsigned char* lds, float lam, const float* subln_g) {
    const int tid = threadIdx.x, lane = tid & 63, r32 = lane & 31, hi = lane >> 5; const int wid = __builtin_amdgcn_readfirstlane(tid >> 6);
    const int c = wid >> 2, wq = wid & 3;
    const size_t rowbase = (size_t)b * SEQ; const int q0 = qb * 128;
    const int NT = 2 * qb + 2, ntw = 2 * qb + 1 + (wq >> 1);
    const bf16_t* Kh = Kg + rowbase * 1024 + h * 128; const bf16_t* Vh = Vg + rowbase * 1024 + h * 128;
    const int krow = wid * 8 + (lane >> 3);
    const bf16_t* ksrc0 = Kh + (size_t)krow * 1024 + (((lane & 7) ^ ((krow >> 1) & 7)) * 8); const bf16_t* ksrc1 = ksrc0 + 64;
    const bf16_t* vsrc0 = Vh + (size_t)((wid & 3) * 16 + (lane >> 2)) * 1024 + (wid >> 2) * 32 + (lane & 3) * 8; const bf16_t* vsrc1 = vsrc0 + 64;
    const unsigned kd0 = wid * 1024, kd1 = (wid + 8) * 1024;
    const unsigned lds0 = (unsigned)(uintptr_t)lds;
#define ATT_DMA(t, slot) do { const size_t _o = (size_t)(t) * 64 * 1024; const unsigned _d = (unsigned)__builtin_amdgcn_readfirstlane(lds0 + (slot) * SLOT); \
        glds16(ksrc0 + _o, _d + KOFF + kd0); glds16(ksrc1 + _o, _d + KOFF + kd1); glds16(vsrc0 + _o, _d + VOFF + kd0); glds16(vsrc1 + _o, _d + VOFF + kd1); } while (0)
    const bf16_t* Qw = Qg + (rowbase + q0 + wq * 32 + r32) * 1024 + h * 128 + c * 64 + hi * 8;
    bf16x8 qr[4];
#pragma unroll
    for (int d0 = 0; d0 < 4; ++d0) qr[d0] = *(const bf16x8*)(Qw + d0 * 16);
    asm volatile("" : "+v"(qr[0]), "+v"(qr[1]), "+v"(qr[2]), "+v"(qr[3]) :: "memory");
    ATT_DMA(0, 0); ATT_DMA(1, 1); if (NT > 2) ATT_DMA(2, 2);
    f32x16 o[4];
#pragma unroll
    for (int d = 0; d < 4; ++d)
#pragma unroll
        for (int r = 0; r < 16; ++r) o[d][r] = 0.f;
    LAS float* wsf = (LAS float*)(lds + WSF_OFF) + wid * 64;
    const int kxr = (r32 >> 1) & 7, krb = c * 8192 + r32 * 128;
    const int vro = (4 * hi + ((lane & 15) >> 2)) * 64 + ((lane >> 4) & 1) * 32 + (lane & 3) * 8;
#define ATT_QK(P0, P1, slot_) do { const LAS unsigned char* Ks = lds + (slot_) * SLOT + KOFF + krb; \
        _Pragma("unroll") for (int d0 = 0; d0 < 4; ++d0) { const int ko = ((2 * d0 + hi) ^ kxr) * 16; const bf16x8 k0 = *(const LAS bf16x8*)(Ks + ko), k1 = *(const LAS bf16x8*)(Ks + ko + 4096); \
            if (d0 == 0) { P0 = __builtin_amdgcn_mfma_f32_32x32x16_bf16(k0, qr[0], negm, 0, 0, 0); P1 = __builtin_amdgcn_mfma_f32_32x32x16_bf16(k1, qr[0], negm, 0, 0, 0); } \
            else { P0 = __builtin_amdgcn_mfma_f32_32x32x16_bf16(k0, qr[d0], P0, 0, 0, 0); P1 = __builtin_amdgcn_mfma_f32_32x32x16_bf16(k1, qr[d0], P1, 0, 0, 0); } } } while (0)
#define ATT_SMPV(P0, P1, slot_) do { const LAS unsigned char* Vs = lds + (slot_) * SLOT + VOFF + vro; \
        float mx = max3f(P0[0], P0[1], P1[0]), mx2 = max3f(P0[2], P0[3], P1[1]); mx = max3f(mx, P1[2], P1[3]); \
        _Pragma("unroll") for (int r = 4; r < 16; r += 4) { mx = max3f(mx, P0[r], P0[r + 1]); mx2 = max3f(mx2, P0[r + 2], P0[r + 3]); mx = max3f(mx, P1[r], P1[r + 1]); mx2 = max3f(mx2, P1[r + 2], P1[r + 3]); } \
        mx = fmaxf(mx, mx2); { auto rr = __builtin_amdgcn_permlane32_swap(__float_as_uint(mx), __float_as_uint(mx), false, false); mx = fmaxf(__uint_as_float(rr[0]), __uint_as_float(rr[1])); } \
        if (__builtin_expect(__any(mx > 6.0f), 0)) { const float dl = fmaxf(mx, 0.f), alpha = __builtin_amdgcn_exp2f(-dl); m_run += dl; l_run *= alpha; \
            _Pragma("unroll") for (int r = 0; r < 16; ++r) { P0[r] -= dl; P1[r] -= dl; negm[r] = -m_run; } \
            if (hi == 0) wsf[r32] = alpha; \
            _Pragma("unroll") for (int g = 0; g < 4; ++g) { const f32x4 a4 = *(const LAS f32x4*)(wsf + 8 * g + 4 * hi); \
                _Pragma("unroll") for (int d = 0; d < 4; ++d) _Pragma("unroll") for (int k = 0; k < 4; ++k) o[d][4 * g + k] *= a4[k]; } } \
        float ls = 0.f, ls2 = 0.f; \
        _Pragma("unroll") for (int r = 0; r < 16; ++r) { P0[r] = __builtin_amdgcn_exp2f(P0[r]); P1[r] = __builtin_amdgcn_exp2f(P1[r]); ls += P0[r]; ls2 += P1[r]; } \
        l_run += ls + ls2; \
        bf16x8 pw[4]; \
        _Pragma("unroll") for (int s = 0; s < 2; ++s) { u32x4 w0, w1; \
            _Pragma("unroll") for (int q = 0; q < 4; ++q) { w0[q] = pk2(P0[8 * s + 2 * q], P0[8 * s + 2 * q + 1]); w1[q] = pk2(P1[8 * s + 2 * q], P1[8 * s + 2 * q + 1]); } \
            pw[s] = __builtin_bit_cast(bf16x8, w0); pw[2 + s] = __builtin_bit_cast(bf16x8, w1); } \
        _Pragma("unroll") for (int d = 0; d < 4; ++d) _Pragma("unroll") for (int ks = 0; ks < 4; ++ks) { const s16x4 lo = vtr(Vs + d * 4096 + ks * 1024), hh = vtr(Vs + d * 4096 + ks * 1024 + 512); \
            const bf16x8 vf = (bf16x8){lo[0], lo[1], lo[2], lo[3], hh[0], hh[1], hh[2], hh[3]}; \
            o[d] = __builtin_amdgcn_mfma_f32_32x32x16_bf16(pw[ks], vf, o[d], 0, 0, 0); } } while (0)
    f32x16 sa0, sa1, negm;
#pragma unroll
    for (int r = 0; r < 16; ++r) negm[r] = 0.f;
    float m_run = 0.f, l_run = 0.f;
    int slot = 0, pslot = 3;
    for (int t = 0; t < NT; ++t) {
        const int rem = NT - 1 - t;
        if (rem >= 2) asm volatile("s_waitcnt vmcnt(8) lgkmcnt(0)" ::: "memory"); else if (rem == 1) asm volatile("s_waitcnt vmcnt(4) lgkmcnt(0)" ::: "memory"); else asm volatile("s_waitcnt vmcnt(0) lgkmcnt(0)" ::: "memory");
        __builtin_amdgcn_s_barrier(); asm volatile("" ::: "memory");
        if (t + 3 < NT) ATT_DMA(t + 3, pslot);
        if (t < ntw) {
            ATT_QK(sa0, sa1, slot);
            if (t == 0) {
                float mx = max3f(sa0[0], sa0[1], sa1[0]), mx2 = max3f(sa0[2], sa0[3], sa1[1]); mx = max3f(mx, sa1[2], sa1[3]);
#pragma unroll
                for (int r = 4; r < 16; r += 4) { mx = max3f(mx, sa0[r], sa0[r + 1]); mx2 = max3f(mx2, sa0[r + 2], sa0[r + 3]); mx = max3f(mx, sa1[r], sa1[r + 1]); mx2 = max3f(mx2, sa1[r + 2], sa1[r + 3]); }
                mx = fmaxf(mx, mx2); { auto rr = __builtin_amdgcn_permlane32_swap(__float_as_uint(mx), __float_as_uint(mx), false, false); mx = fmaxf(__uint_as_float(rr[0]), __uint_as_float(rr[1])); }
                m_run = mx;
#pragma unroll
                for (int r = 0; r < 16; ++r) { sa0[r] -= mx; sa1[r] -= mx; negm[r] = -mx; } }
            ATT_SMPV(sa0, sa1, slot);
        }
        pslot = slot; slot = (slot == 3) ? 0 : slot + 1;
    }
#undef ATT_QK
#undef ATT_SMPV
    { const float lt = l_run + __shfl_xor(l_run, 32); const float inv = 1.0f / lt;
      if (hi == 0) wsf[r32] = inv;
#pragma unroll
      for (int g = 0; g < 4; ++g) { const f32x4 a4 = *(const LAS f32x4*)(wsf + 8 * g + 4 * hi);
#pragma unroll
          for (int d = 0; d < 4; ++d)
#pragma unroll
              for (int k = 0; k < 4; ++k) o[d][4 * g + k] *= a4[k]; } }
    asm volatile("s_waitcnt lgkmcnt(0)" ::: "memory"); __builtin_amdgcn_s_barrier(); asm volatile("" ::: "memory");
    LAS float* stg = (LAS float*)(lds + wq * STG_BYTES);
    if (c == 1) {
#pragma unroll
        for (int d = 0; d < 4; ++d)
#pragma unroll
            for (int r = 0; r < 16; ++r) stg[crow(r, hi) * STG_ROW + d * 32 + r32] = o[d][r];
    }
    asm volatile("s_waitcnt lgkmcnt(0)" ::: "memory"); __builtin_amdgcn_s_barrier(); asm volatile("" ::: "memory");
    if (c == 0) {
#pragma unroll
        for (int d = 0; d < 4; ++d)
#pragma unroll
            for (int r = 0; r < 16; ++r) { LAS float* p = stg + crow(r, hi) * STG_ROW + d * 32 + r32; *p = o[d][r] - lam * (*p); }
        asm volatile("s_waitcnt lgkmcnt(0)" ::: "memory");
        const int row = lane >> 1, hf = lane & 1; const LAS float* rp = stg + row * STG_ROW + hf * 64;
        f32x4 v[16]; float ss = 0.f;
#pragma unroll
        for (int i = 0; i < 16; ++i) { v[i] = *(const LAS f32x4*)(rp + 4 * i); ss += v[i][0] * v[i][0] + v[i][1] * v[i][1] + v[i][2] * v[i][2] + v[i][3] * v[i][3]; }
        ss += __shfl_xor(ss, 1);
        const float rs = (1.0f - LAM_INIT) / sqrtf(ss * (1.0f / 128.0f) + RMS_EPS);
        bf16_t* op = Og + (rowbase + q0 + wq * 32 + row) * 1024 + h * 128 + hf * 64; const float* gp = subln_g + hf * 64;
#pragma unroll
        for (int i = 0; i < 8; ++i) { const f32x4 ga = *(const f32x4*)(gp + 8 * i), gb = *(const f32x4*)(gp + 8 * i + 4); const f32x4 a = v[2 * i] * ga * rs, bq = v[2 * i + 1] * gb * rs;
            u32x4 w; w.x = pk2(a[0], a[1]); w.y = pk2(a[2], a[3]); w.z = pk2(bq[0], bq[1]); w.w = pk2(bq[2], bq[3]); *(u32x4*)(op + 8 * i) = w; }
    }
    asm volatile("s_waitcnt lgkmcnt(0)" ::: "memory"); __builtin_amdgcn_s_barrier(); asm volatile("" ::: "memory");
#undef ATT_DMA
}
}

namespace rg {
constexpr int CW_OFF = 0  , AGG_OFF = 2048  ;
__device__ __forceinline__ int crow(int r, int hi) { return (r & 3) + 8 * (r >> 2) + 4 * hi; }

__device__ __forceinline__ void rglru_unit(int b, int n, int hf, const bf16_t* XR, const bf16_t* YG, bf16_t* YO, const float* conv_w, const float* conv_b,
                                           const float* w_a, const float* b_a, const float* w_i, const float* b_i, const float* lam, LAS unsigned char* lds) {
    const int tid = threadIdx.x, lane = tid & 63, r32 = lane & 31, hi = lane >> 5; const int wid = __builtin_amdgcn_readfirstlane(tid >> 6);
    const int c0 = n * 64 + hf * 32, ch = c0 + r32;
    LAS float* cw = (LAS float*)(lds + CW_OFF);
    if (tid < 256) cw[tid] = conv_w[(tid >> 6) * 1024 + n * 64 + (tid & 63)]; else if (tid < 320) cw[tid] = conv_b[n * 64 + (tid - 256)];
    bf16x8 wa[4], wi[4], idm[2];
#pragma unroll
    for (int s = 0; s < 4; ++s) { u32x4 ua, ui;
#pragma unroll
        for (int q = 0; q < 4; ++q) { const size_t o0 = ((size_t)n * 64 + 16 * s + 8 * hi + 2 * q) * 64 + hf * 32 + r32;
            ua[q] = pk2(w_a[o0], w_a[o0 + 64]); ui[q] = pk2(w_i[o0], w_i[o0 + 64]); }
        wa[s] = __builtin_bit_cast(bf16x8, ua); wi[s] = __builtin_bit_cast(bf16x8, ui); }
#pragma unroll
    for (int s = 0; s < 2; ++s) { u32x4 ud;
#pragma unroll
        for (int q = 0; q < 4; ++q) { const int k0 = 16 * s + 8 * hi + 2 * q; ud[q] = (k0 == r32 ? 0x3f80u : 0u) | (k0 + 1 == r32 ? 0x3f800000u : 0u); }
        idm[s] = __builtin_bit_cast(bf16x8, ud); }
    const float ba = b_a[ch], bi = b_i[ch];
    const float lmb = lam[ch]; const float sp = (lmb < -20.f) ? -lmb : log1pf(expf(-lmb));
    const float nsp8 = -8.0f * sp * LOG2E;
    float carry = 0.f;
    const size_t rowbase = (size_t)b * SEQ;
    __syncthreads();
    u32x4 xv[4][4]; bf16x8 ya[2];
#define RG_LOAD(bt_) do { const int _t0 = (bt_) * 256 + wid * 32; \
        int _xo = (int)((rowbase + _t0 + r32) * 1024 + n * 64 + 8 * hi); asm volatile("" : "+v"(_xo));     \
        _Pragma("unroll") for (int s = 0; s < 4; ++s) _Pragma("unroll") for (int tap = 0; tap < 4; ++tap) xv[s][tap] = *(const u32x4*)(XR + _xo + (tap - 3) * 1024 + 16 * s);     \
        int _yo = (int)((rowbase + _t0 + r32) * 1024 + c0 + 8 * hi); asm volatile("" : "+v"(_yo)); \
        _Pragma("unroll") for (int s = 0; s < 2; ++s) ya[s] = *(const bf16x8*)(YG + _yo + 16 * s); } while (0)
    RG_LOAD(0);
    for (int bt = 0; bt < SEQ / 256; ++bt) {
        const int t0 = bt * 256 + wid * 32;
        bf16x8 xa[4];
#pragma unroll
        for (int s = 0; s < 4; ++s) { const int cl = 16 * s + 8 * hi; float v[8];
            { const f32x4 b0 = *(const LAS f32x4*)(cw + 256 + cl), b1 = *(const LAS f32x4*)(cw + 256 + cl + 4);
#pragma unroll
              for (int j = 0; j < 4; ++j) { v[j] = b0[j]; v[4 + j] = b1[j]; } }
#pragma unroll
            for (int tap = 0; tap < 4; ++tap) { const int tt = t0 + r32 - 3 + tap;
                u32x4 x4 = xv[s][tap]; if (tt < 0) x4 = (u32x4){0u, 0u, 0u, 0u};
                const f32x4 w0 = *(const LAS f32x4*)(cw + tap * 64 + cl), w1 = *(const LAS f32x4*)(cw + tap * 64 + cl + 4);
                v[0] += w0[0] * bf_lo(x4[0]); v[1] += w0[1] * bf_hi(x4[0]); v[2] += w0[2] * bf_lo(x4[1]); v[3] += w0[3] * bf_hi(x4[1]);
                v[4] += w1[0] * bf_lo(x4[2]); v[5] += w1[1] * bf_hi(x4[2]); v[6] += w1[2] * bf_lo(x4[3]); v[7] += w1[3] * bf_hi(x4[3]); }
            u32x4 pw; pw.x = pk2(v[0], v[1]); pw.y = pk2(v[2], v[3]); pw.z = pk2(v[4], v[5]); pw.w = pk2(v[6], v[7]); xa[s] = __builtin_bit_cast(bf16x8, pw); }
        f32x16 ga, gi, xc, yg;
#pragma unroll
        for (int r = 0; r < 16; ++r) { ga[r] = 0.f; gi[r] = 0.f; xc[r] = 0.f; yg[r] = 0.f; }
#pragma unroll
        for (int s = 0; s < 4; ++s) { ga = __builtin_amdgcn_mfma_f32_32x32x16_bf16(xa[s], wa[s], ga, 0, 0, 0); gi = __builtin_amdgcn_mfma_f32_32x32x16_bf16(xa[s], wi[s], gi, 0, 0, 0); }
        if (hf == 0) { xc = __builtin_amdgcn_mfma_f32_32x32x16_bf16(xa[0], idm[0], xc, 0, 0, 0); xc = __builtin_amdgcn_mfma_f32_32x32x16_bf16(xa[1], idm[1], xc, 0, 0, 0); }
        else         { xc = __builtin_amdgcn_mfma_f32_32x32x16_bf16(xa[2], idm[0], xc, 0, 0, 0); xc = __builtin_amdgcn_mfma_f32_32x32x16_bf16(xa[3], idm[1], xc, 0, 0, 0); }
        yg = __builtin_amdgcn_mfma_f32_32x32x16_bf16(ya[0], idm[0], yg, 0, 0, 0); yg = __builtin_amdgcn_mfma_f32_32x32x16_bf16(ya[1], idm[1], yg, 0, 0, 0);
        if (bt + 1 < SEQ / 256) RG_LOAD(bt + 1);
        float a[16], u[16];
#pragma unroll
        for (int r = 0; r < 16; ++r) { const float rr = fast_sigmoid(ga[r] + ba), ii = fast_sigmoid(gi[r] + bi);
            const float av = __builtin_amdgcn_exp2f(nsp8 * rr); a[r] = av; u[r] = xc[r] * ii * __builtin_amdgcn_sqrtf(fmaxf(1.0f - av * av, 0.f)); if ((r & 3) == 3) __builtin_amdgcn_sched_barrier(0); }
        float mA[4], mB[4], oA[4], oB[4];
#pragma unroll
        for (int g = 0; g < 4; ++g) { float A = a[4 * g], Bv = u[4 * g];
#pragma unroll
            for (int k = 1; k < 4; ++k) { A *= a[4 * g + k]; Bv = Bv * a[4 * g + k] + u[4 * g + k]; }
            mA[g] = A; mB[g] = Bv; oA[g] = __shfl_xor(A, 32); oB[g] = __shfl_xor(Bv, 32); }
        __builtin_amdgcn_sched_barrier(0);
        float TA = 1.f, TB = 0.f;
#pragma unroll
        for (int g = 0; g < 4; ++g) { const float fA = hi ? oA[g] : mA[g], fB = hi ? oB[g] : mB[g], sA = hi ? mA[g] : oA[g], sB = hi ? mB[g] : oB[g];
            TB = TB * fA + fB; TA *= fA; TB = TB * sA + sB; TA *= sA; }
        LAS f32x2* agg = (LAS f32x2*)(lds + AGG_OFF) + (bt & 1) * 256;
        if (hi == 0) agg[wid * 32 + r32] = (f32x2){TA, TB};
        asm volatile("s_waitcnt lgkmcnt(0)" ::: "memory"); __builtin_amdgcn_s_barrier(); asm volatile("" ::: "memory");
        float hin = carry, hall = carry;
#pragma unroll
        for (int w = 0; w < 8; ++w) { const f32x2 ab = agg[w * 32 + r32]; hall = hall * ab[0] + ab[1]; if (w < wid) hin = hall; }
        carry = hall;
        float s = hin;
        int so = (int)((rowbase + t0 + 4 * hi) * 1024 + ch); asm volatile("" : "+v"(so));
#pragma unroll
        for (int g = 0; g < 4; ++g) { float st;
            if (hi) { s = s * oA[g] + oB[g]; st = s; s = s * mA[g] + mB[g]; } else { st = s; s = s * mA[g] + mB[g]; s = s * oA[g] + oB[g]; }
#pragma unroll
            for (int k = 0; k < 4; ++k) { st = st * a[4 * g + k] + u[4 * g + k];
                YO[so + (8 * g + k) * 1024] = (bf16_t)f2bf(st * yg[4 * g + k]); }
            __builtin_amdgcn_sched_barrier(0); }
    }
    __syncthreads();
#undef RG_LOAD
}
}

constexpr int NWAVES = 8;
#ifndef MK_N_LAUNCHES
#define MK_N_LAUNCHES 1
#endif
constexpr int N_PHASES = 14;
constexpr int RING_OFF = 0, RING_BYTES = 131072;
constexpr int TAB_OFF = RING_BYTES;
constexpr int TAB_TP = TAB_OFF, TAB_CNT = TAB_OFF + 272, TAB_RT2E = TAB_OFF + 544, TAB_END = TAB_RT2E + 704;
constexpr int LDSCTL_OFF = RING_BYTES + 2048, MISC_OFF = LDSCTL_OFF + 320;
constexpr int LDS_BYTES = 147456;
static_assert(TAB_END <= LDSCTL_OFF && MISC_OFF + 128 <= LDS_BYTES, "LDS map");

typedef GAS unsigned gu32;
#define RLX_AGENT __ATOMIC_RELAXED, __HIP_MEMORY_SCOPE_AGENT
#define LDS_WAIT() asm volatile("s_waitcnt lgkmcnt(0)" ::: "memory")
#define VM_WAIT() asm volatile("s_waitcnt vmcnt(0)" ::: "memory")

#define XB_TMO      128
#define XB_XCNT(j)  (256  + 64 * (j))
#define XB_XSUB(j)  (1280 + 64 * (j))
#define XB_XGEN(j)  (2304 + 64 * (j))
#define XB_TOP      3328
#define XB_TOPGEN   3392
#define XCD_BAR_WORDS 3456
#define XB_SPIN_CAP (1u << 18)
__device__ __forceinline__ unsigned xb_ld(unsigned* p)              { return __hip_atomic_load(p, __ATOMIC_RELAXED, __HIP_MEMORY_SCOPE_AGENT); }
__device__ __forceinline__ unsigned xb_add(unsigned* p, unsigned v) { return __hip_atomic_fetch_add(p, v, __ATOMIC_RELAXED, __HIP_MEMORY_SCOPE_AGENT); }
__device__ __forceinline__ unsigned xb_xcc_id() { return (unsigned)__builtin_amdgcn_s_getreg((3 << 11) | 20) & 0xFu; }
#define XB_SPIN(cond, bar) do { unsigned _sp = 0; while (cond) { __builtin_amdgcn_s_sleep(1); \
    if ((++_sp & 255u) == 0u) { if (xb_ld(&(bar)[XB_TMO])) break; if (_sp > XB_SPIN_CAP) { atomicAdd(&(bar)[XB_TMO], 1u); break; } } } } while (0)
struct XcdBarrier { unsigned* bar; unsigned x; volatile LAS unsigned* st; };
__device__ __forceinline__ XcdBarrier xcd_barrier_post(unsigned* bar, volatile LAS unsigned* st) {
    XcdBarrier b; b.bar = bar; b.x = xb_xcc_id(); b.st = st;
    if (threadIdx.x == 0) (void)xb_add(&bar[XB_XCNT(b.x)], 1u);
    return b;
}
__device__ __forceinline__ void xcd_barrier_complete(unsigned* bar, unsigned x, unsigned& nloc, unsigned& nx) {
    const unsigned G = gridDim.x * gridDim.y * gridDim.z;
    unsigned sum, cnt, mine, sp = 0u;
    for (;;) {
        sum = 0u; cnt = 0u; mine = 0u;
#pragma unroll
        for (unsigned j = 0; j < 16; ++j) { const unsigned c = xb_ld(&bar[XB_XCNT(j)]); sum += c; cnt += (c > 0u) ? 1u : 0u; mine = (j == x) ? c : mine; }
        if (sum == G) break;
        __builtin_amdgcn_s_sleep(1);
        if ((++sp & 255u) == 0u) { if (xb_ld(&bar[XB_TMO])) break; if (sp > XB_SPIN_CAP) { atomicAdd(&bar[XB_TMO], 1u); break; } }
    }
    nloc = mine > 0u ? mine : 1u; nx = cnt > 0u ? cnt : 1u;
}
__device__ __forceinline__ void xcd_barrier(const XcdBarrier& b) {
    asm volatile("s_waitcnt vmcnt(0)" ::: "memory");
    __syncthreads();
    if (threadIdx.x == 0) {
        unsigned* bar = b.bar;
        __builtin_amdgcn_s_waitcnt(0);
        unsigned nloc = b.st[0], nx = b.st[1];
        if (nloc == 0u) { xcd_barrier_complete(bar, b.x, nloc, nx); b.st[0] = nloc; b.st[1] = nx; }
        const unsigned old = xb_add(&bar[XB_XSUB(b.x)], 1u);
        const unsigned gen = old / nloc;
        if (old + 1u == (gen + 1u) * nloc) {
            __builtin_amdgcn_fence(__ATOMIC_RELEASE, "agent");
            asm volatile("s_waitcnt vmcnt(0)" ::: "memory");
            const unsigned og = xb_add(&bar[XB_TOP], 1u);
            const unsigned tg = og / nx;
            if (og + 1u == (tg + 1u) * nx) xb_add(&bar[XB_TOPGEN], 1u);
            else XB_SPIN(xb_ld(&bar[XB_TOPGEN]) == tg, bar);
            __builtin_amdgcn_fence(__ATOMIC_ACQUIRE, "agent");
            xb_add(&bar[XB_XGEN(b.x)], 1u);
            asm volatile("s_waitcnt vmcnt(0)" ::: "memory");
        } else {
            XB_SPIN(xb_ld(&bar[XB_XGEN(b.x)]) == gen, bar);
            __builtin_amdgcn_fence(__ATOMIC_ACQUIRE, "agent");
            asm volatile("s_waitcnt vmcnt(0)" ::: "memory");
        }
    }
    __syncthreads();
}

struct Inputs {
    const float *x, *c, *w_ada, *b_ada, *w_in, *conv_w, *conv_b, *lru_w_a, *lru_b_a, *lru_w_i, *lru_b_i, *lru_lambda,
                *lam_q1, *lam_k1, *lam_q2, *lam_k2, *subln_g, *p_rnn, *p_attn, *w_out, *ln1_g, *ln1_b,
                *w_router, *router_bias, *we_gate, *we_up, *we_down, *ws_gate, *ws_up, *ws_down, *ln2_g, *ln2_b;
};
struct Args { Inputs in; float* out; unsigned char* ws; int ph_lo, ph_hi, li, pad; };

__device__ __forceinline__ float wave_sum(float v) {
#pragma unroll
    for (int o = 1; o < 64; o <<= 1) v += __shfl_xor(v, o);
    return v;
}

__device__ __forceinline__ void transpose_item(const float* W, int ldw, int k0, int n0, bf16_t* WT, size_t ldo, int orow0, int ocol0, LAS float* scr, int lane) {
#pragma unroll 8
    for (int i = 0; i < 32; ++i) { const int kk = 2 * i + (lane >> 5); scr[kk * 33 + (lane & 31)] = W[(size_t)(k0 + kk) * ldw + n0 + (lane & 31)]; }
    LDS_WAIT(); asm volatile("" ::: "memory");
    const int c = lane & 7;
#pragma unroll
    for (int j = 0; j < 4; ++j) { const int n = (lane >> 3) + 8 * j; const LAS float* s = scr + (8 * c) * 33 + n;
        u32x4 o; o.x = pk2(s[0 * 33], s[1 * 33]); o.y = pk2(s[2 * 33], s[3 * 33]); o.z = pk2(s[4 * 33], s[5 * 33]); o.w = pk2(s[6 * 33], s[7 * 33]);
        *(GAS u32x4*)(WT + (size_t)(orow0 + n) * ldo + ocol0 + k0 + 8 * c) = o; }
    LDS_WAIT(); asm volatile("" ::: "memory");
}

__global__ void __launch_bounds__(NWAVES * 64, 2) mk_fwd(Args args) {
    extern __shared__ __attribute__((aligned(16))) unsigned char lds_raw[];
    LAS unsigned char* lds = (LAS unsigned char*)lds_raw;
    volatile LAS unsigned* MISC = (volatile LAS unsigned*)(lds + MISC_OFF);
    const int tid = threadIdx.x, lane = tid & 63, wave = __builtin_amdgcn_readfirstlane(tid >> 6);
    const int G = gridDim.x; const int bx = blockIdx.x; const int vcu = (G % 8 == 0) ? (bx % 8) * (G / 8) + bx / 8 : bx;
    const int gw = vcu * NWAVES + wave, NGW = G * NWAVES;
    unsigned char* ws = args.ws; const Inputs& I = args.in;
    gu32* ctl = (gu32*)(ws + WS_CTL);
    float* ADA = (float*)(ws + WS_ADA);
    bf16_t* WIN = (bf16_t*)(ws + WS_WIN); bf16_t* WBR = (bf16_t*)(ws + WS_WBR); bf16_t* WOUT = (bf16_t*)(ws + WS_WOUT); bf16_t* WRTR = (bf16_t*)(ws + WS_WRTR);
    bf16_t* W1 = (bf16_t*)(ws + WS_W1); bf16_t* W2 = (bf16_t*)(ws + WS_W2);
    bf16_t* HB = (bf16_t*)(ws + WS_HB); bf16_t* XR = (bf16_t*)(ws + WS_XR); bf16_t* YG = (bf16_t*)(ws + WS_YG); bf16_t* QB = (bf16_t*)(ws + WS_Q);
    bf16_t* KB = (bf16_t*)(ws + WS_K); bf16_t* VB = (bf16_t*)(ws + WS_V); bf16_t* GB = (bf16_t*)(ws + WS_G); bf16_t* MRG = (bf16_t*)(ws + WS_XR);
    bf16_t* UB = (bf16_t*)(ws + WS_U); float* LOGITS = (float*)(ws + WS_LOG); unsigned* LIST = (unsigned*)(ws + WS_LIST); float* TOKW = (float*)(ws + WS_TOKW);
    bf16_t* HX = (bf16_t*)(ws + WS_H); bf16_t* YS = (bf16_t*)(ws + WS_Y);
    float* OUT = args.out;

    for (int u = tid; u < (LDS_BYTES - LDSCTL_OFF) / 4; u += NWAVES * 64) ((LAS unsigned*)(lds + LDSCTL_OFF))[u] = 0u;
    __syncthreads();
    XcdBarrier bar; bar.bar = (unsigned*)(ctl + CW_BAR); bar.x = 0; bar.st = nullptr;
    if (MK_N_LAUNCHES == 1) bar = xcd_barrier_post((unsigned*)(ctl + CW_BAR), MISC + 8);
    const int lo = args.ph_lo, hi = args.ph_hi;
#ifndef PH_MASK
#define PH_MASK 0xFFFF
#endif
#define IN(k) ((((PH_MASK) >> (k)) & 1) && lo <= (k) && (k) < hi)
#ifndef REP_PHASE
#define REP_PHASE -1
#endif
#define NREP(k) (((k) == REP_PHASE) ? 2 : 1)
#define SEAM(k) do { if (IN(k) && IN((k) + 1)) xcd_barrier(bar); } while (0)

    if (IN(0)) for (int rep = 0; rep < NREP(0); ++rep) {
        if (vcu < 96) {
            LAS float* sc = (LAS float*)(lds + RING_OFF);
            LAS float* red = (LAS float*)(lds + RING_OFF + 32768);
            for (int i = tid; i < 8192; i += NWAVES * 64) { const int b = i >> 10, k = i & 1023; const float cv = I.c[i]; sc[k * 8 + b] = cv * fast_sigmoid(cv); }
            __syncthreads();
            float a8[8];
#pragma unroll
            for (int b = 0; b < 8; ++b) a8[b] = 0.f;
            const float* wp = I.w_ada + (size_t)(wave * 128) * 6144 + vcu * 64 + lane;
#pragma unroll 8
            for (int k = 0; k < 128; ++k) { const float w = wp[(size_t)k * 6144]; const f32x4 s0 = *(const LAS f32x4*)(sc + (wave * 128 + k) * 8), s1 = *(const LAS f32x4*)(sc + (wave * 128 + k) * 8 + 4);
                a8[0] += s0[0] * w; a8[1] += s0[1] * w; a8[2] += s0[2] * w; a8[3] += s0[3] * w; a8[4] += s1[0] * w; a8[5] += s1[1] * w; a8[6] += s1[2] * w; a8[7] += s1[3] * w; }
#pragma unroll
            for (int b = 0; b < 8; ++b) red[(wave * 8 + b) * 64 + lane] = a8[b];
            __syncthreads();
            { const int b = wave; float s = I.b_ada[vcu * 64 + lane];
#pragma unroll
              for (int w = 0; w < 8; ++w) s += red[(w * 8 + b) * 64 + lane];
              ADA[(size_t)b * 6144 + vcu * 64 + lane] = s; }
            __syncthreads();
        }
        LAS float* scr = (LAS float*)(lds + RING_OFF + wave * 16384);
        constexpr int I_IN = 16 * 224, I_SQ = 16 * 32, I_RT = 16 * 2, I_DN = 4 * 32;
        constexpr int NIT = I_IN + 3 * I_SQ + I_RT + NEXP1 * I_DN;
        for (int it = gw; it < NIT; it += NGW) {
            int r = it;
            if (r < I_IN) { transpose_item(I.w_in, DIN, 64 * (r / 224), 32 * (r % 224), WIN, 1024, 32 * (r % 224), 0, scr, lane); continue; } r -= I_IN;
            if (r < I_SQ) { transpose_item(I.p_rnn, 1024, 64 * (r / 32), 32 * (r % 32), WBR, 2048, 32 * (r % 32), 0, scr, lane); continue; } r -= I_SQ;
            if (r < I_SQ) { transpose_item(I.p_attn, 1024, 64 * (r / 32), 32 * (r % 32), WBR, 2048, 32 * (r % 32), 1024, scr, lane); continue; } r -= I_SQ;
            if (r < I_SQ) { transpose_item(I.w_out, 1024, 64 * (r / 32), 32 * (r % 32), WOUT, 1024, 32 * (r % 32), 0, scr, lane); continue; } r -= I_SQ;
            if (r < I_RT) { transpose_item(I.w_router, 64, 64 * (r / 2), 32 * (r % 2), WRTR, 1024, 32 * (r % 2), 0, scr, lane); continue; } r -= I_RT;
            { const int e = r / I_DN, q = r % I_DN; const float* src = (e < NEXP) ? I.we_down + (size_t)e * 256 * 1024 : I.ws_down;
              transpose_item(src, 1024, 64 * (q / 32), 32 * (q % 32), W2 + (size_t)e * 1024 * 256, 256, 32 * (q % 32), 0, scr, lane); }
        }
        for (int i = gw * 64 + lane; i < 192 * 1024 / 8; i += NGW * 64) *(u32x4*)(WRTR + 64 * 1024 + (size_t)i * 8) = (u32x4){0u, 0u, 0u, 0u};
    }
    SEAM(0);

    if (IN(1)) for (int rep = 0; rep < NREP(1); ++rep) {
        for (int m = gw; m < M; m += NGW) {
            const float* ada = ADA + (size_t)(m / SEQ) * 6144;
            const GAS f32x4* xr = (const GAS f32x4*)(I.x + (size_t)m * DM) + lane;
            f32x4 v[4]; float s = 0.f;
#pragma unroll
            for (int j = 0; j < 4; ++j) { v[j] = xr[64 * j]; s += (v[j].x + v[j].y) + (v[j].z + v[j].w); }
            const float mean = wave_sum(s) * (1.f / DM); float s2 = 0.f;
#pragma unroll
            for (int j = 0; j < 4; ++j) { v[j] = v[j] - mean; s2 += (v[j].x * v[j].x + v[j].y * v[j].y) + (v[j].z * v[j].z + v[j].w * v[j].w); }
            const float rstd = 1.f / sqrtf(wave_sum(s2) * (1.f / DM) + LN_EPS);
            GAS u32x2* o8 = (GAS u32x2*)(HB + (size_t)m * DM) + lane;
#pragma unroll
            for (int j = 0; j < 4; ++j) { const f32x4 sh = *((const f32x4*)ada + lane + 64 * j), sc = *((const f32x4*)(ada + 1024) + lane + 64 * j);
                const f32x4 y = v[j] * rstd * (sc + 1.0f) + sh; o8[64 * j] = (u32x2){pk2(y.x, y.y), pk2(y.z, y.w)}; }
        }
    }
    SEAM(1);

    if (IN(2)) for (int rep = 0; rep < NREP(2); ++rep) {
        pg8::Gemm g{HB, WIN, 1024, 1 << 30, 0}; pg8::DenseSched S; S.init(M, DIN, 1024, G, bx, 2048u);
        pg8::EpiInProj E{XR, YG, QB, KB, VB, GB};
        pg8::gemm_phase<pg8::EpiInProj, pg8::DenseSched, true>(lds + RING_OFF, g, S, E);
    }
    SEAM(2);

    if (IN(3)) {
        for (int rep = 0; rep < NREP(3); ++rep) for (int u = vcu; u < 256; u += G) rg::rglru_unit(u >> 5, (u >> 1) & 15, u & 1, XR, YG, (NREP(3) == 2 && rep == 0) ? HB : YG, I.conv_w, I.conv_b, I.lru_w_a, I.lru_b_a, I.lru_w_i, I.lru_b_i, I.lru_lambda, lds + RING_OFF);
        const float s1 = wave_sum(I.lam_q1[lane] * I.lam_k1[lane]), s2 = wave_sum(I.lam_q2[lane] * I.lam_k2[lane]);
        const float lam = expf(s1) - expf(s2) + LAM_INIT;
        for (int rep = 0; rep < NREP(30); ++rep) for (int v = vcu; v < 256; v += G) { const int bh = v >> 2, j = v & 3;
#pragma unroll 1
            for (int i = 0; i < 4; ++i) { const int qb = (i == 0) ? 15 - j : (i == 1) ? 8 + j : (i == 2) ? 7 - j : j;
                att::attn_unit(bh >> 3, bh & 7, qb, QB, KB, VB, (NREP(30) == 2 && rep == 0) ? HB : QB, lds + RING_OFF, lam, I.subln_g); } }
    }
    SEAM(3);

    if (IN(4)) for (int rep = 0; rep < NREP(4); ++rep) {
        pg8::Gemm g{YG, WBR, 2048, 16, (long)(WS_Q - WS_YG) - 16 * 128}; pg8::DenseSched S; S.init(M, 1024, 2048, G, bx, 2048u);
        pg8::EpiBranch E{GB, MRG};
        pg8::gemm_phase<pg8::EpiBranch, pg8::DenseSched, true>(lds + RING_OFF, g, S, E);
    }
    SEAM(4);

    if (IN(5)) for (int rep = 0; rep < NREP(5); ++rep) {
        pg8::Gemm g{MRG, WOUT, 1024, 1 << 30, 0}; pg8::DenseSched S; S.init(M, 1024, 1024, G, bx, 2048u);
        pg8::EpiOutProj E{I.x, ADA, OUT};
        pg8::gemm_phase<pg8::EpiOutProj, pg8::DenseSched, true>(lds + RING_OFF, g, S, E);
    }
    SEAM(5);

    if (IN(6)) {
        for (int m = gw; m < M; m += NGW) {
            const float* ada = ADA + (size_t)(m / SEQ) * 6144;
            GAS f32x4* xr = (GAS f32x4*)(OUT + (size_t)m * DM) + lane;
            f32x4 v[4]; float s = 0.f;
#pragma unroll
            for (int j = 0; j < 4; ++j) { v[j] = xr[64 * j]; s += (v[j].x + v[j].y) + (v[j].z + v[j].w); }
            float mean = wave_sum(s) * (1.f / DM), s2 = 0.f;
#pragma unroll
            for (int j = 0; j < 4; ++j) { v[j] = v[j] - mean; s2 += (v[j].x * v[j].x + v[j].y * v[j].y) + (v[j].z * v[j].z + v[j].w * v[j].w); }
            float rstd = 1.f / sqrtf(wave_sum(s2) * (1.f / DM) + LN_EPS);
            s = 0.f;
#pragma unroll
            for (int j = 0; j < 4; ++j) { const f32x4 gg = *((const f32x4*)I.ln1_g + lane + 64 * j), bb = *((const f32x4*)I.ln1_b + lane + 64 * j);
                v[j] = v[j] * rstd * gg + bb; xr[64 * j] = v[j]; s += (v[j].x + v[j].y) + (v[j].z + v[j].w); }
            mean = wave_sum(s) * (1.f / DM); s2 = 0.f;
#pragma unroll
            for (int j = 0; j < 4; ++j) { v[j] = v[j] - mean; s2 += (v[j].x * v[j].x + v[j].y * v[j].y) + (v[j].z * v[j].z + v[j].w * v[j].w); }
            rstd = 1.f / sqrtf(wave_sum(s2) * (1.f / DM) + LN_EPS);
            GAS u32x2* o8 = (GAS u32x2*)(UB + (size_t)m * DM) + lane;
#pragma unroll
            for (int j = 0; j < 4; ++j) { const f32x4 sh = *((const f32x4*)(ada + 3072) + lane + 64 * j), sc = *((const f32x4*)(ada + 4096) + lane + 64 * j);
                const f32x4 y = v[j] * rstd * (sc + 1.0f) + sh; o8[64 * j] = (u32x2){pk2(y.x, y.y), pk2(y.z, y.w)}; }
        }
    }
    SEAM(6);

    if (IN(7)) for (int rep = 0; rep < NREP(7); ++rep) {
        { pg8::Gemm g{UB, WRTR, 1024, 1 << 30, 0}; pg8::DenseSched S; S.init(M, 256, 1024, G, bx, 2048u);
          pg8::EpiRouter E{LOGITS};
          pg8::gemm_phase<pg8::EpiRouter, pg8::DenseSched, true>(lds + RING_OFF, g, S, E); }
        __syncthreads();
        LAS float* scr = (LAS float*)(lds + RING_OFF + wave * 16384);
        constexpr int I_GU = 16 * 8, NIT = NEXP1 * 2 * I_GU;
        for (int it = gw; it < NIT; it += NGW) { const int e = it / (2 * I_GU), r = it % (2 * I_GU), up = r / I_GU, q = r % I_GU, n0 = 32 * (q % 8);
            const float* src = (e < NEXP) ? (up ? I.we_up : I.we_gate) + (size_t)e * 1024 * 256 : (up ? I.ws_up : I.ws_gate);
            transpose_item(src, 256, 64 * (q / 8), n0, W1 + (size_t)e * 512 * 1024, 1024, (n0 >> 7) * 256 + up * 128 + (n0 & 127), 0, scr, lane); }
    }
    SEAM(7);

    if (IN(8)) {
        LAS float* sl = (LAS float*)(lds + RING_OFF);
        LAS float* sv = sl + 64 * 65;
        LAS unsigned* hist = (LAS unsigned*)(sv + 64 * 65);
        LAS unsigned* base = hist + 64;
        for (int tg = vcu; tg < M / 64; tg += G) {
            for (int i = tid; i < 64 * 64; i += NWAVES * 64) { const int t = i >> 6, e = i & 63; const float s = fast_sigmoid(LOGITS[(size_t)(tg * 64 + t) * 64 + e]); sv[t * 65 + e] = s; sl[t * 65 + e] = s + I.router_bias[e]; }
            if (tid < 64) hist[tid] = 0u;
            __syncthreads();
            if (wave == 0) {
                const LAS float* ms = sl + lane * 65; const LAS float* mv = sv + lane * 65;
                float gs[8];
#pragma unroll
                for (int g = 0; g < 8; ++g) { float t1 = -INFINITY, t2 = -INFINITY;
#pragma unroll
                    for (int j = 0; j < 8; ++j) { const float x = ms[g * 8 + j]; if (x > t1) { t2 = t1; t1 = x; } else if (x > t2) t2 = x; }
                    gs[g] = t1 + t2; }
                unsigned gmask = 0u;
#pragma unroll
                for (int r = 0; r < 4; ++r) { float best = -INFINITY; int bi = 0;
#pragma unroll
                    for (int g = 0; g < 8; ++g) { const bool ok = !((gmask >> g) & 1u) && gs[g] > best; best = ok ? gs[g] : best; bi = ok ? g : bi; }
                    gmask |= 1u << bi; }
                unsigned long long picked = 0ull; int ei[8]; float wv[8]; float wsum = 0.f;
#pragma unroll
                for (int r = 0; r < 8; ++r) { float best = -INFINITY; int bi = 0;
                    for (int e = 0; e < 64; ++e) { const float x = ms[e]; const bool ok = ((gmask >> (e >> 3)) & 1u) && !((picked >> e) & 1ull) && x > best; best = ok ? x : best; bi = ok ? e : bi; }
                    picked |= 1ull << bi; ei[r] = bi; wv[r] = mv[bi]; wsum += wv[r]; }
                const float wn = 2.5f / wsum; const unsigned tok = (unsigned)(tg * 64 + lane); unsigned pos[8];
#pragma unroll
                for (int r = 0; r < 8; ++r) { pos[r] = atomicAdd((unsigned*)&hist[ei[r]], 1u); TOKW[(size_t)tok * 8 + r] = wv[r] * wn; }
                LDS_WAIT();
                { const unsigned hc = hist[lane]; base[lane] = hc ? __hip_atomic_fetch_add(ctl + CW_CNT + 64 * lane, hc, RLX_AGENT) : 0u; }
                LDS_WAIT();
#pragma unroll
                for (int r = 0; r < 8; ++r) LIST[(size_t)ei[r] * M + base[ei[r]] + pos[r]] = tok * 16u + (unsigned)r;
            }
            __syncthreads();
        }
    }
    SEAM(8);

    pg8::ExpertTables ET; ET.tp = (const LAS int*)(lds + TAB_TP); ET.cnt = (const LAS int*)(lds + TAB_CNT); ET.rt2e = (const LAS unsigned char*)(lds + TAB_RT2E); ET.RT = 0;
    if (hi > 9) {
        LAS int* tp = (LAS int*)(lds + TAB_TP); LAS int* cn = (LAS int*)(lds + TAB_CNT); LAS unsigned char* r2e = (LAS unsigned char*)(lds + TAB_RT2E);
        if (tid < NEXP1) cn[tid] = (tid < NEXP) ? (int)__hip_atomic_load(ctl + CW_CNT + 64 * tid, RLX_AGENT) : M;
        __syncthreads();
        if (tid == 0) { int acc = 0; for (int e = 0; e < NEXP1; ++e) { tp[e] = acc; acc += (cn[e] + 255) >> 8; } tp[NEXP1] = acc; }
        __syncthreads();
        const int RT = tp[NEXP1];
        for (int e = wave; e < NEXP1; e += NWAVES) for (int rt = tp[e] + lane; rt < tp[e + 1]; rt += 64) r2e[rt] = (unsigned char)e;
        __syncthreads();
        ET.RT = RT;
    }

    if (IN(9)) for (int rep = 0; rep < NREP(9); ++rep) {
        pg8::Gemm g{UB, W1, 1024, 1 << 30, 0};
        pg8::ExpertSched S; S.T = ET; S.nN = 2; S.G = G; S.c = bx; S.list = LIST; S.mode = 0; S.bstride = W1_STRIDE; S.bsub = 256 * 1024 * 2; S.pn0 = 0;
        pg8::EpiGemm1 E{ET, LIST, TOKW, HX};
        pg8::gemm_phase<pg8::EpiGemm1, pg8::ExpertSched, true>(lds + RING_OFF, g, S, E);
    }
    SEAM(9);

#pragma unroll 1
    for (int half = 0; half < 2; ++half) {
        if (IN(10 + 2 * half)) for (int rep = 0; rep < NREP(10); ++rep) {
            pg8::Gemm g{HX, W2, 256, 1 << 30, 0};
            pg8::ExpertSched S; S.T = ET; S.nN = 2; S.G = G; S.c = bx; S.list = LIST; S.mode = 1; S.bstride = W2_STRIDE; S.bsub = 256 * 256 * 2; S.pn0 = 2 * half;
            pg8::EpiGemm2 E{LIST, YS, args.pad};
            pg8::gemm_phase<pg8::EpiGemm2, pg8::ExpertSched, true>(lds + RING_OFF, g, S, E);
        }
        SEAM(10 + 2 * half);
        if (IN(11 + 2 * half)) {
            for (int m = gw; m < M; m += NGW) {
                const float* ada = ADA + (size_t)(m / SEQ) * 6144;
                float a[8];
#pragma unroll
                for (int j = 0; j < 8; ++j) a[j] = 0.f;
#pragma unroll
                for (int k = 0; k < NSLOTK; ++k) { const u32x4 y = *(const u32x4*)(YS + ((size_t)m * NSLOTK + k) * 512 + lane * 8);
#pragma unroll
                    for (int q = 0; q < 4; ++q) { a[2 * q] += bf_lo(y[q]); a[2 * q + 1] += bf_hi(y[q]); } }
                float* op = OUT + (size_t)m * DM + half * 512 + lane * 8; const float* g2 = ada + 5120 + half * 512 + lane * 8;
                f32x4 x0 = *(const f32x4*)op, x1 = *(const f32x4*)(op + 4); const f32x4 ga = *(const f32x4*)g2, gb = *(const f32x4*)(g2 + 4);
                x0 = x0 * ALPHA_DN + ga * (f32x4){a[0], a[1], a[2], a[3]}; x1 = x1 * ALPHA_DN + gb * (f32x4){a[4], a[5], a[6], a[7]};
                if (half == 0) { *(f32x4*)op = x0; *(f32x4*)(op + 4) = x1; }
                else { const float* pp = OUT + (size_t)m * DM + lane * 8; f32x4 p0 = *(const f32x4*)pp, p1 = *(const f32x4*)(pp + 4);
                    float s = (p0.x + p0.y) + (p0.z + p0.w) + (p1.x + p1.y) + (p1.z + p1.w) + (x0.x + x0.y) + (x0.z + x0.w) + (x1.x + x1.y) + (x1.z + x1.w);
                    const float mean = wave_sum(s) * (1.f / DM); p0 = p0 - mean; p1 = p1 - mean; x0 = x0 - mean; x1 = x1 - mean;
                    float s2 = (p0.x * p0.x + p0.y * p0.y) + (p0.z * p0.z + p0.w * p0.w) + (p1.x * p1.x + p1.y * p1.y) + (p1.z * p1.z + p1.w * p1.w)
                             + (x0.x * x0.x + x0.y * x0.y) + (x0.z * x0.z + x0.w * x0.w) + (x1.x * x1.x + x1.y * x1.y) + (x1.z * x1.z + x1.w * x1.w);
                    const float rstd = 1.f / sqrtf(wave_sum(s2) * (1.f / DM) + LN_EPS);
                    const float* lg = I.ln2_g + lane * 8; const float* lb = I.ln2_b + lane * 8;
                    *(f32x4*)pp = p0 * rstd * *(const f32x4*)lg + *(const f32x4*)lb; *(f32x4*)(pp + 4) = p1 * rstd * *(const f32x4*)(lg + 4) + *(const f32x4*)(lb + 4);
                    *(f32x4*)op = x0 * rstd * *(const f32x4*)(lg + 512) + *(const f32x4*)(lb + 512); *(f32x4*)(op + 4) = x1 * rstd * *(const f32x4*)(lg + 516) + *(const f32x4*)(lb + 516); }
            }
        }
        if (half == 0) SEAM(11);
    }
#undef IN
#undef SEAM
}

extern "C" void kernel_launch(void* const* d_in, const int* in_sizes, int n_in, void* d_out, int out_size, void* d_ws, size_t ws_size, hipStream_t stream) {
    static int grid = 0;
    if (grid == 0) {
        if (n_in != 32 || in_sizes[0] != M * DM || out_size != M * DM || ws_size < WS_END) { fprintf(stderr, "kernel_launch: unexpected shapes / workspace (n_in %d, ws %zu < %zu); nothing launched\n", n_in, ws_size, (size_t)WS_END); grid = -1; return; }
        int dev = 0, cus = 0, per_cu = 0;
        if (hipGetDevice(&dev) != hipSuccess || hipDeviceGetAttribute(&cus, hipDeviceAttributeMultiprocessorCount, dev) != hipSuccess) { grid = -1; return; }
        if (hipFuncSetAttribute((const void*)mk_fwd, hipFuncAttributeMaxDynamicSharedMemorySize, LDS_BYTES) != hipSuccess) { fprintf(stderr, "kernel_launch: hipFuncSetAttribute failed\n"); grid = -1; return; }
        if (hipOccupancyMaxActiveBlocksPerMultiprocessor(&per_cu, (const void*)mk_fwd, NWAVES * 64, LDS_BYTES) != hipSuccess || per_cu < 1) { fprintf(stderr, "kernel_launch: occupancy query reports %d\n", per_cu); }
        (void)hipGetLastError();
        grid = cus;
    }
    if (grid < 0) return;
    (void)hipMemsetAsync((char*)d_ws + WS_CTL, 0, CTL_ZERO_BYTES, stream);
    Args a{};
    const float** ip = (const float**)&a.in;
    for (int i = 0; i < 32; ++i) ip[i] = (const float*)d_in[i];
    a.out = (float*)d_out; a.ws = (unsigned char*)d_ws;
    if (MK_N_LAUNCHES == 1) { a.ph_lo = 0; a.ph_hi = N_PHASES; a.li = 0; hipLaunchKernelGGL(mk_fwd, dim3(grid), dim3(NWAVES * 64), LDS_BYTES, stream, a); }
    else for (int p = 0; p < N_PHASES; ++p) { a.ph_lo = p; a.ph_hi = p + 1; a.li = p; hipLaunchKernelGGL(mk_fwd, dim3(grid), dim3(NWAVES * 64), LDS_BYTES, stream, a);
#ifdef HOST_REP
#ifndef HOST_REP_FLAG
#define HOST_REP_FLAG 0
#endif
        if (p == HOST_REP) { a.pad = HOST_REP_FLAG; hipLaunchKernelGGL(mk_fwd, dim3(grid), dim3(NWAVES * 64), LDS_BYTES, stream, a); a.pad = 0; }
#endif
    }
}
```
